# Optimizing an MI355X kernel written in HIP

```python
import jax, jax.numpy as jnp
from jax import lax
import numpy as np

D_MODEL = 1024
BATCH = 16
SEQ = 2048
DEPTH = 4

A_HEADS = 4
A_DK = 128
A_DV = 128
A_WIDTH = A_HEADS * A_DV
B_HEADS = 4
B_DK = 64
B_DV = 128
B_QK = B_HEADS * B_DK
B_WIDTH = B_HEADS * B_DV
C_HEADS = 4
C_DK = 64
C_DV = 128
C_QK = C_HEADS * C_DK
C_WIDTH = C_HEADS * C_DV
GLA_RANK = 16
GLA_TAU = 16.0
N_BRANCH = 3
SPLIT_SIZES = (
    A_WIDTH, A_HEADS * A_DK, A_HEADS * A_DK, A_WIDTH, A_WIDTH,
    B_QK, B_QK, B_WIDTH, B_WIDTH,
    C_QK, C_QK, C_WIDTH, C_WIDTH,
    2 * GLA_RANK,
    D_MODEL, D_MODEL, D_MODEL,
)
N_IN = 5 * A_WIDTH + 2 * B_QK + 2 * B_WIDTH + 2 * C_QK + 2 * C_WIDTH + 2 * GLA_RANK + N_BRANCH * D_MODEL
D_FF = ((8 * D_MODEL + 3 * 256 - 1) // (3 * 256)) * 256
CHUNK = 64
ROPE_BASE = 10000.0
EPS = 1e-6
TINY = 1e-30

kernel_name = "hybrid_hgrn2_retnet_gla_adaln_encoder"


def rms_norm(x, gain):
    x32 = x.astype(jnp.float32)
    y = x32 * lax.rsqrt(jnp.mean(x32 * x32, axis=-1, keepdims=True) + EPS)
    return (y * gain.astype(jnp.float32)).astype(x.dtype)


def head_rms(o):
    return o * lax.rsqrt(jnp.mean(o * o, axis=-1, keepdims=True) + EPS)


def head_group_norm(o):
    mu = jnp.mean(o, axis=-1, keepdims=True)
    var = jnp.mean(jnp.square(o - mu), axis=-1, keepdims=True)
    return (o - mu) * lax.rsqrt(var + EPS)


def rotary(x):
    seqlen, d = x.shape[1], x.shape[-1]
    pos = jnp.arange(seqlen, dtype=jnp.float32)
    inv_freq = ROPE_BASE ** (-jnp.arange(0, d, 2, dtype=jnp.float32) / d)
    ang = pos[:, None] * inv_freq[None, :]
    cos = jnp.cos(ang)[None, :, None, :]
    sin = jnp.sin(ang)[None, :, None, :]
    x32 = x.astype(jnp.float32)
    x1, x2 = x32[..., : d // 2], x32[..., d // 2:]
    return jnp.concatenate([x1 * cos - x2 * sin, x1 * sin + x2 * cos], axis=-1).astype(x.dtype)


def chunked_gated_linear_attention(q, k, v, log_g, inclusive):
    bsz, seqlen, heads, dk = q.shape
    dv = v.shape[-1]
    n = seqlen // CHUNK

    def blocks(a):
        a = a.astype(jnp.float32).reshape(bsz, n, CHUNK, heads, a.shape[-1])
        return a.transpose(1, 0, 3, 2, 4)

    mask = jnp.tril(jnp.ones((CHUNK, CHUNK), dtype=bool), k=0 if inclusive else -1)[:, :, None]

    def step(state, inp):
        qb, kb, vb, gb = inp
        cum = jnp.cumsum(gb, axis=2)
        last = cum[:, :, -1:, :]
        diff = jnp.where(mask, cum[:, :, :, None, :] - cum[:, :, None, :, :], 0.0)
        rel = jnp.where(mask, jnp.exp(diff), 0.0)
        scores = jnp.einsum('bhid,bhjd,bhijd->bhij', qb, kb, rel)
        out = (jnp.einsum('bhij,bhjv->bhiv', scores, vb)
               + jnp.einsum('bhid,bhdv->bhiv', qb * jnp.exp(cum), state))
        state = (state * jnp.exp(last[:, :, 0, :, None])
                 + jnp.einsum('bhjd,bhjv->bhdv', kb * jnp.exp(last - cum), vb))
        return state, out

    init = jnp.zeros((bsz, heads, dk, dv), jnp.float32)
    _, out = lax.scan(step, init, (blocks(q), blocks(k), blocks(v), blocks(log_g)))
    return out.transpose(1, 0, 3, 2, 4).reshape(bsz, seqlen, heads, dv)


def bidirectional_scan(q, k_fwd, k_bwd, v, log_g_fwd, log_g_bwd):
    fwd = chunked_gated_linear_attention(q, k_fwd, v, log_g_fwd, True)
    flip = lambda a: jnp.flip(a, axis=1)
    bwd = flip(chunked_gated_linear_attention(flip(q), flip(k_bwd), flip(v), flip(log_g_bwd), False))
    return fwd + bwd


def retention_log_decay(reverse):
    h = jnp.arange(B_HEADS, dtype=jnp.float32)
    if reverse:
        h = h[::-1]
    return jnp.log1p(-jnp.exp2(-5.0 - h))


def hgrn2_lower_bounds(lb_logits):
    p = jax.nn.softmax(lb_logits.astype(jnp.float32), axis=0)
    return jnp.maximum(jnp.cumsum(p, axis=0) - p[0:1], 0.0)


def mixer_sublayer(h, lb, norm_a_g, norm_b_g, norm_c_g, w_in, w_alpha, b_alpha, w_pa, w_pb, w_pc, w_out):
    bsz, seqlen, _ = h.shape
    dt = h.dtype
    z = h @ w_in
    idx = np.cumsum(SPLIT_SIZES)[:-1]
    (a_q, a_ff, a_fb, a_i, a_g, b_q, b_k, b_v, b_g, c_q, c_k, c_v, c_g, c_lr,
     gate_a, gate_b, gate_c) = jnp.split(z, idx, axis=-1)
    heads = lambda t, n: t.reshape(bsz, seqlen, n, -1)

    lb32 = lb.astype(jnp.float32).reshape(A_HEADS, A_DK)
    def forget(zf):
        zf = heads(zf, A_HEADS).astype(jnp.float32)
        f = lb32 + (1.0 - lb32) * jax.nn.sigmoid(zf)
        log_f = jnp.log(jnp.maximum(f, TINY))
        key = (1.0 - lb32) * jax.nn.sigmoid(-zf)
        return log_f, key
    log_f_fwd, key_fwd = forget(a_ff)
    log_f_bwd, key_bwd = forget(a_fb)
    qa = heads(jax.nn.silu(a_q), A_HEADS)
    o_a = bidirectional_scan(qa, key_fwd, key_bwd, heads(a_i, A_HEADS), log_f_fwd, log_f_bwd)
    y_a = (head_rms(o_a).reshape(bsz, seqlen, A_WIDTH) * norm_a_g).astype(dt) * jax.nn.sigmoid(a_g)

    qb = rotary(heads(b_q, B_HEADS))
    kb = rotary(heads(b_k, B_HEADS)) * (B_DK ** -0.5)
    shape_b = (bsz, seqlen, B_HEADS, B_DK)
    lg_fwd = jnp.broadcast_to(retention_log_decay(False)[None, None, :, None], shape_b)
    lg_bwd = jnp.broadcast_to(retention_log_decay(True)[None, None, :, None], shape_b)
    o_b = bidirectional_scan(qb, kb, kb, heads(b_v, B_HEADS), lg_fwd, lg_bwd)
    y_b = (head_group_norm(o_b).reshape(bsz, seqlen, B_WIDTH) * norm_b_g).astype(dt) * jax.nn.silu(b_g)

    lr = c_lr.reshape(bsz, seqlen, 2, GLA_RANK)
    alpha_logits = jnp.einsum('btnr,nrk->btnk', lr, w_alpha) + b_alpha
    log_alpha = jax.nn.log_sigmoid(alpha_logits.astype(jnp.float32)) / GLA_TAU
    la_fwd = heads(log_alpha[:, :, 0], C_HEADS)
    la_bwd = heads(log_alpha[:, :, 1], C_HEADS)
    qc = heads(c_q, C_HEADS) * (C_DK ** -0.5)
    kc = heads(c_k, C_HEADS)
    o_c = bidirectional_scan(qc, kc, kc, heads(c_v, C_HEADS), la_fwd, la_bwd)
    y_c = (head_rms(o_c).reshape(bsz, seqlen, C_WIDTH) * norm_c_g).astype(dt) * jax.nn.silu(c_g)

    merged = (jax.nn.sigmoid(gate_a) * (y_a @ w_pa)
              + jax.nn.sigmoid(gate_b) * (y_b @ w_pb)
              + jax.nn.sigmoid(gate_c) * (y_c @ w_pc))
    return merged @ w_out


def setup_inputs(seed: int = 0) -> dict:
    key = jax.random.key(seed)
    ks = jax.random.split(key, 24)
    f32 = jnp.float32
    nrm = lambda k, shape, scale: jax.random.normal(k, shape, f32) * scale
    gain = lambda k, shape: 1.0 + 0.01 * jax.random.normal(k, shape, f32)
    return {
        "x": jax.random.normal(ks[0], (BATCH, SEQ, D_MODEL), f32),
        "c": jax.random.normal(ks[1], (BATCH, D_MODEL), f32),
        "norm1_g": gain(ks[2], (DEPTH, D_MODEL)),
        "w_ada": nrm(ks[3], (DEPTH, D_MODEL, 6 * D_MODEL), D_MODEL ** -0.5),
        "b_ada": nrm(ks[4], (DEPTH, 6 * D_MODEL), 0.01),
        "w_in": nrm(ks[5], (DEPTH, D_MODEL, N_IN), D_MODEL ** -0.5),
        "lb_logits": nrm(ks[6], (DEPTH, A_HEADS * A_DK), 0.5),
        "norm_a_g": gain(ks[7], (DEPTH, A_WIDTH)),
        "norm_b_g": gain(ks[8], (DEPTH, B_WIDTH)),
        "norm_c_g": gain(ks[9], (DEPTH, C_WIDTH)),
        "w_alpha": nrm(ks[10], (DEPTH, 2, GLA_RANK, C_QK), GLA_RANK ** -0.5),
        "b_alpha": nrm(ks[11], (DEPTH, 2, C_QK), 0.1),
        "w_pa": nrm(ks[12], (DEPTH, A_WIDTH, D_MODEL), A_WIDTH ** -0.5),
        "w_pb": nrm(ks[13], (DEPTH, B_WIDTH, D_MODEL), B_WIDTH ** -0.5),
        "w_pc": nrm(ks[14], (DEPTH, C_WIDTH, D_MODEL), C_WIDTH ** -0.5),
        "w_out": nrm(ks[15], (DEPTH, D_MODEL, D_MODEL), D_MODEL ** -0.5),
        "norm2_g": gain(ks[16], (DEPTH, D_MODEL)),
        "w_ffn_in": nrm(ks[17], (DEPTH, D_MODEL, 2 * D_FF), D_MODEL ** -0.5),
        "w_ffn_out": nrm(ks[18], (DEPTH, D_FF, D_MODEL), D_FF ** -0.5),
        "norm_f_g": gain(ks[19], (D_MODEL,)),
    }


def reference(x, c, norm1_g, w_ada, b_ada, w_in, lb_logits, norm_a_g, norm_b_g, norm_c_g,
              w_alpha, b_alpha, w_pa, w_pb, w_pc, w_out, norm2_g, w_ffn_in, w_ffn_out, norm_f_g):
    lower_bounds = hgrn2_lower_bounds(lb_logits)
    c_act = jax.nn.silu(c)
    for l in range(DEPTH):
        mod = c_act @ w_ada[l] + b_ada[l]
        sh1, sc1, g1, sh2, sc2, g2 = [m[:, None, :] for m in jnp.split(mod, 6, axis=-1)]
        h = rms_norm(x, norm1_g[l]) * (1.0 + sc1) + sh1
        x = x + g1 * mixer_sublayer(h, lower_bounds[l], norm_a_g[l], norm_b_g[l], norm_c_g[l], w_in[l],
                                    w_alpha[l], b_alpha[l], w_pa[l], w_pb[l], w_pc[l], w_out[l])
        h2 = rms_norm(x, norm2_g[l]) * (1.0 + sc2) + sh2
        gate, up = jnp.split(h2 @ w_ffn_in[l], 2, axis=-1)
        x = x + g2 * ((jax.nn.silu(gate) * up) @ w_ffn_out[l])
    return rms_norm(x, norm_f_g)
```

```cpp
#include <hip/hip_runtime.h>
#include <hip/hip_cooperative_groups.h>
#include <cstdio>
namespace cg = cooperative_groups;

#ifndef MULTI_LAUNCH
#define MULTI_LAUNCH 0
#endif

#define LAS __attribute__((address_space(3)))
typedef unsigned short bf16_t;
typedef short bf16x8 __attribute__((ext_vector_type(8)));
typedef float f32x4 __attribute__((ext_vector_type(4)));
typedef unsigned u32x4 __attribute__((ext_vector_type(4)));
typedef unsigned u32x2 __attribute__((ext_vector_type(2)));

constexpr int D = 1024, BATCH = 16, SEQ = 2048, DEPTH = 4;
constexpr int GB = 8;
constexpr int NGRP = BATCH / GB;
constexpr int MH = GB * SEQ;
constexpr int NIN = 8736, NZ = 9216, DFF = 2816;
constexpr int LDS_MAIN = 155648;
constexpr int LDS_BYTES = LDS_MAIN + 16;
constexpr int ZA_Q = 0, ZA_FF = 512, ZA_FB = 1024, ZA_I = 1536, ZA_G = 2048;
constexpr int ZB_Q = 2560, ZB_K = 2816, ZB_V = 3072, ZB_G = 3584;
constexpr int ZC_Q = 4096, ZC_K = 4352, ZC_V = 4608, ZC_G = 5120, ZC_LG = 8704;
constexpr int ZG_A = 5632;

struct Params {
    const float *x, *c, *norm1_g, *w_ada, *b_ada, *w_in, *lb_logits, *norm_a_g, *norm_b_g, *norm_c_g, *w_alpha, *b_alpha,
                *w_pa, *w_pb, *w_pc, *w_out, *norm2_g, *w_ffn_in, *w_ffn_out, *norm_f_g;
    float* out;
    bf16_t *wt_in;
    bf16_t *wt_p;
    bf16_t *wt_out;
    bf16_t *wt_fi;
    bf16_t *wt_fo;
    float *mod;
    float *lb;
    float2 *rope;
    bf16_t *h;
    bf16_t *h2;
    bf16_t *z;
    bf16_t *o;
    unsigned *bar;
};

__device__ __forceinline__ float bf2f(bf16_t h) { return __uint_as_float(((unsigned)h) << 16); }
__device__ __forceinline__ bf16_t f2bf(float f) { unsigned u = __float_as_uint(f); u += 0x7fffu + ((u >> 16) & 1u); return (bf16_t)(u >> 16); }
__device__ __forceinline__ unsigned pk2(float lo, float hi) { return (unsigned)f2bf(lo) | ((unsigned)f2bf(hi) << 16); }
typedef __bf16 bf16x2_t __attribute__((ext_vector_type(2)));
typedef float f32x2_t __attribute__((ext_vector_type(2)));
__device__ __forceinline__ unsigned cvt_pk_bf16(float lo, float hi) { const f32x2_t f = {lo, hi}; const bf16x2_t v = __builtin_convertvector(f, bf16x2_t); return __builtin_bit_cast(unsigned, v); }
__device__ __forceinline__ float sigmoidf_(float x) { return __builtin_amdgcn_rcpf(1.0f + __expf(-x)); }
__device__ __forceinline__ float clampf(float x, float lo, float hi) { return fminf(fmaxf(x, lo), hi); }

namespace pg8 {
constexpr int BM = 256, BK = 64, HALF = 128, HTB = HALF * BK * 2, STAGE_BYTES = 8 * HTB, NXCD = 8, WGM = 8;
__host__ __device__ __forceinline__ int lds_byte(int r, int c) { const int st = (r >> 4) * 2 + (c >> 5), rr = r & 15, cc = c & 31, ob = rr * 64 + cc * 2; return st * 1024 + (ob ^ (((ob >> 9) & 1) << 5)); }
__host__ __device__ __forceinline__ void stage_rc(int b, int& R, int& C) { const int st = b / 1024, sb = b % 1024, swz = sb ^ (((sb >> 9) & 1) << 5); R = (st >> 1) * 16 + swz / 64; C = (st & 1) * 32 + (swz % 64) / 2; }
__host__ __device__ __forceinline__ int perm32(int rho) { const int n = rho >> 4, i = rho & 15; return 8 * (i >> 2) + 4 * n + (i & 3); }

struct Unit { int pm, pn; };
struct Gemm { const bf16_t* A; const bf16_t* Bt; int lda, ldb, K; };

struct StaticOrder {
    int nM, nN, nwg, G, c;
    __device__ void init(int M, int N, int G_, int c_) { nM = M / BM; nN = N / BM; nwg = nM * nN; G = G_; c = c_; }
    __device__ bool next(int i, Unit& u) const {
        const long L = (long)i * G + c; if (L >= nwg) return false;
        int wgid = (int)L; { const int q = nwg / NXCD, r = nwg % NXCD, xcd = wgid % NXCD, off = wgid / NXCD; wgid = (xcd < r ? xcd * (q + 1) : r * (q + 1) + (xcd - r) * q) + off; }
        const int nig = WGM * nN, gid = wgid / nig, fm = gid * WGM, gsz = (nM - fm) < WGM ? (nM - fm) : WGM;
        u.pm = fm + ((wgid % nig) % gsz); u.pn = (wgid % nig) / gsz; return true;
    }
};
struct ProjOrder {
    StaticOrder base;
    __device__ bool next(int i, Unit& u) const { if (!base.next(i, u)) return false; u.pn = (u.pn + 22) % 36; return true; }
};
struct MergeOrder {
    StaticOrder base;
    __device__ bool next(int i, Unit& u) const { Unit t; if (!base.next(i / 3, t)) return false; const int br = i % 3; u.pm = br * (MH / BM) + t.pm; u.pn = br * (D / BM) + t.pn; return true; }
};

typedef f32x4 Acc[2][2][4][2];
__device__ __forceinline__ void zero_acc(Acc& acc) {
#pragma unroll
    for (int a = 0; a < 2; ++a)
#pragma unroll
        for (int b = 0; b < 2; ++b)
#pragma unroll
            for (int m = 0; m < 4; ++m)
#pragma unroll
                for (int n = 0; n < 2; ++n) acc[a][b][m][n] = (f32x4){0.f, 0.f, 0.f, 0.f};
}

struct EpiZ {
    static constexpr bool PERM = true;
    bf16_t* O; int ldc;
    __device__ __forceinline__ void operator()(Acc& acc, const Unit& u, int wr, int wc, int fr, int fq) const {
        const int row0 = u.pm * BM + wr * 64 + fr, col0 = u.pn * BM + wc * 32 + 8 * fq;
#pragma unroll
        for (int ai = 0; ai < 2; ++ai)
#pragma unroll
            for (int m = 0; m < 4; ++m) { bf16_t* rowp = O + (size_t)(row0 + ai * HALF + m * 16) * ldc + col0;
#pragma unroll
                for (int bj = 0; bj < 2; ++bj) { f32x4 v0 = acc[ai][bj][m][0], v1 = acc[ai][bj][m][1];
                    if (u.pn < 2) {
#pragma unroll
                        for (int j = 0; j < 4; ++j) { v0[j] *= sigmoidf_(v0[j]); v1[j] *= sigmoidf_(v1[j]); } }
                    else if ((u.pn >= 2 && u.pn < 6) || (u.pn >= 22 && u.pn < 34)) {
#pragma unroll
                        for (int j = 0; j < 4; ++j) { v0[j] = sigmoidf_(v0[j]); v1[j] = sigmoidf_(v1[j]); } }
                    u32x4 w; w.x = cvt_pk_bf16(v0[0], v0[1]); w.y = cvt_pk_bf16(v0[2], v0[3]); w.z = cvt_pk_bf16(v1[0], v1[1]); w.w = cvt_pk_bf16(v1[2], v1[3]);
                    *(u32x4*)(rowp + bj * HALF) = w; } }
        zero_acc(acc);
    }
};
struct EpiAct {
    static constexpr bool PERM = true;
    bf16_t* O; int ldc;
    __device__ __forceinline__ void operator()(Acc& acc, const Unit& u, int wr, int wc, int fr, int fq) const {
        const int row0 = u.pm * BM + wr * 64 + fr, col0 = u.pn * HALF + wc * 32 + 8 * fq;
#pragma unroll
        for (int ai = 0; ai < 2; ++ai)
#pragma unroll
            for (int m = 0; m < 4; ++m) { bf16_t* rowp = O + (size_t)(row0 + ai * HALF + m * 16) * ldc + col0;
                float r[8];
#pragma unroll
                for (int n = 0; n < 2; ++n)
#pragma unroll
                    for (int j = 0; j < 4; ++j) { const float g = acc[ai][0][m][n][j], up = acc[ai][1][m][n][j]; r[n * 4 + j] = g * sigmoidf_(g) * up; }
                u32x4 w; w.x = cvt_pk_bf16(r[0], r[1]); w.y = cvt_pk_bf16(r[2], r[3]); w.z = cvt_pk_bf16(r[4], r[5]); w.w = cvt_pk_bf16(r[6], r[7]);
                *(u32x4*)rowp = w; }
        zero_acc(acc);
    }
};
struct EpiRes {
    static constexpr bool PERM = true;
    const float* xin; float* xout; const float* gm;
    __device__ __forceinline__ void operator()(Acc& acc, const Unit& u, int wr, int wc, int fr, int fq) const {
        const int row0 = u.pm * BM + wr * 64 + fr, col0 = u.pn * BM + wc * 32 + 8 * fq;
        const float* gb = gm + (size_t)((u.pm * BM) / SEQ) * (6 * D);
        f32x4 gv[2][2];
#pragma unroll
        for (int bj = 0; bj < 2; ++bj)
#pragma unroll
            for (int n = 0; n < 2; ++n) gv[bj][n] = *(const f32x4*)(gb + col0 + bj * HALF + n * 4);
#pragma unroll
        for (int ai = 0; ai < 2; ++ai) {
            f32x4 xi[4][2][2];
#pragma unroll
            for (int m = 0; m < 4; ++m) { const size_t off = (size_t)(row0 + ai * HALF + m * 16) * D + col0;
#pragma unroll
                for (int bj = 0; bj < 2; ++bj)
#pragma unroll
                    for (int n = 0; n < 2; ++n) xi[m][bj][n] = *(const f32x4*)(xin + off + bj * HALF + n * 4); }
#pragma unroll
            for (int m = 0; m < 4; ++m) { const size_t off = (size_t)(row0 + ai * HALF + m * 16) * D + col0;
#pragma unroll
                for (int bj = 0; bj < 2; ++bj)
#pragma unroll
                    for (int n = 0; n < 2; ++n) *(f32x4*)(xout + off + bj * HALF + n * 4) = xi[m][bj][n] + gv[bj][n] * acc[ai][bj][m][n]; }
        }
        zero_acc(acc);
    }
};
struct EpiMerge {
    static constexpr bool PERM = true;
    const bf16_t* z; bf16_t* O;
    __device__ __forceinline__ void operator()(Acc& acc, const Unit& u, int wr, int wc, int fr, int fq) const {
        const int br = u.pm / (MH / BM), pm = u.pm - br * (MH / BM), pn = u.pn - br * (D / BM);
        const int row0 = pm * BM + wr * 64 + fr, col0 = pn * BM + wc * 32 + 8 * fq;
        const bf16_t* zg = z + ZG_A + br * D + col0;
#pragma unroll
        for (int ai = 0; ai < 2; ++ai) {
            u32x4 g0[4][2], g1[4][2];
#pragma unroll
            for (int m = 0; m < 4; ++m) { const size_t row = (size_t)(row0 + ai * HALF + m * 16);
#pragma unroll
                for (int bj = 0; bj < 2; ++bj) { g0[m][bj] = *(const u32x4*)(zg + row * NZ + bj * HALF);
                    if (br < 2) g1[m][bj] = *(const u32x4*)(zg + row * NZ + D + bj * HALF); } }
#pragma unroll
            for (int m = 0; m < 4; ++m) { const size_t row = (size_t)(row0 + ai * HALF + m * 16);
#pragma unroll
                for (int bj = 0; bj < 2; ++bj) {
                    float s[8];
                    if (br < 2) {
#pragma unroll
                        for (int e = 0; e < 4; ++e) {
                            const float a0 = __uint_as_float(g0[m][bj][e] << 16), a1 = __uint_as_float(g0[m][bj][e] & 0xffff0000u);
                            const float b0 = __uint_as_float(g1[m][bj][e] << 16), b1 = __uint_as_float(g1[m][bj][e] & 0xffff0000u);
                            s[2 * e] = a0 * __builtin_amdgcn_rcpf(fmaxf(b0, 1e-30f)); s[2 * e + 1] = a1 * __builtin_amdgcn_rcpf(fmaxf(b1, 1e-30f)); }
#pragma unroll
                        for (int n = 0; n < 2; ++n)
#pragma unroll
                            for (int j = 0; j < 4; ++j) acc[ai][bj][m][n][j] *= s[n * 4 + j];
                    } else {
#pragma unroll
                        for (int e = 0; e < 4; ++e) { s[2 * e] = __uint_as_float(g0[m][bj][e] << 16); s[2 * e + 1] = __uint_as_float(g0[m][bj][e] & 0xffff0000u); }
                        const f32x4 v0 = acc[ai][bj][m][0], v1 = acc[ai][bj][m][1];
                        u32x4 w; w.x = cvt_pk_bf16(v0[0] * s[0], v0[1] * s[1]); w.y = cvt_pk_bf16(v0[2] * s[2], v0[3] * s[3]);
                        w.z = cvt_pk_bf16(v1[0] * s[4], v1[1] * s[5]); w.w = cvt_pk_bf16(v1[2] * s[6], v1[3] * s[7]);
                        *(u32x4*)(O + row * D + col0 + bj * HALF) = w;
                        acc[ai][bj][m][0] = (f32x4){0.f, 0.f, 0.f, 0.f}; acc[ai][bj][m][1] = (f32x4){0.f, 0.f, 0.f, 0.f};
                    } } }
        }
    }
};

template <class Epi, class Sched>
__device__ __forceinline__ void gemm_phase(LAS unsigned char* lds, const Gemm g, const Sched& S, const Epi& E) {
    int tid_ = threadIdx.x; asm volatile("" : "+v"(tid_));
    const int tid = tid_, wid = __builtin_amdgcn_readfirstlane(tid >> 6), lane = tid & 63, wr = wid >> 2, wc = wid & 3, fr = lane & 15, fq = lane >> 4;
    const int K = g.K, nt = K / BK;
    unsigned voffA[2], voffB[2];
#pragma unroll
    for (int i = 0; i < 2; ++i) { int R, C; stage_rc(tid * 16 + i * 8192, R, C); const int Rb = Epi::PERM ? ((R & ~31) + perm32(R & 31)) : R;
        voffA[i] = (unsigned)(R * g.lda + C) * 2u; voffB[i] = (unsigned)(Rb * g.ldb + C) * 2u; }
    const size_t kstep = (size_t)(BK * 2);
    const size_t hstepA = (size_t)HALF * g.lda * 2, hstepB = (size_t)HALF * g.ldb * 2;
    const size_t tstepA = 2 * hstepA, tstepB = 2 * hstepB;
    const unsigned ldsw = (unsigned)wid * 1024u;
    const int aoff = lds_byte(wr * 64 + fr, fq * 8), boff = lds_byte(wc * 32 + fr, fq * 8);
#define PG8_SA(b, h) (((b) * 2 + (h)) * HTB)
#define PG8_SB(b, h) ((4 + (b) * 2 + (h)) * HTB)
#define PG8_STAGE(bufoff, gbase, voff) do { _Pragma("unroll") for (int _i = 0; _i < 2; ++_i) \
        __builtin_amdgcn_global_load_lds((const unsigned*)((const char*)(gbase) + (voff)[_i]), (LAS unsigned*)(lds + (bufoff) + ldsw + _i * 8192), 16, 0, 0); } while (0)
#define PG8_LDA(dst, b, h) do { _Pragma("unroll") for (int m = 0; m < 4; ++m) _Pragma("unroll") for (int k = 0; k < 2; ++k) dst[m][k] = *(const LAS bf16x8*)(lds + PG8_SA(b, h) + aoff + m * 2048 + k * 1024); } while (0)
#define PG8_LDB(dst, b, h) do { _Pragma("unroll") for (int n = 0; n < 2; ++n) _Pragma("unroll") for (int k = 0; k < 2; ++k) dst[n][k] = *(const LAS bf16x8*)(lds + PG8_SB(b, h) + boff + n * 2048 + k * 1024); } while (0)
#define PG8_MMA(ai, bj, At, Bt) do { __builtin_amdgcn_s_setprio(1); _Pragma("unroll") for (int m = 0; m < 4; ++m) _Pragma("unroll") for (int n = 0; n < 2; ++n) _Pragma("unroll") for (int k = 0; k < 2; ++k) \
        acc[ai][bj][m][n] = __builtin_amdgcn_mfma_f32_16x16x32_bf16(Bt[n][k], At[m][k], acc[ai][bj][m][n], 0, 0, 0); __builtin_amdgcn_s_setprio(0); } while (0)
#define PG8_WAIT_V(n) asm volatile("s_waitcnt vmcnt(" #n ")" ::: "memory")
#define PG8_WAIT_L(n) asm volatile("s_waitcnt lgkmcnt(" #n ")" ::: "memory")
#define PG8_BAR __builtin_amdgcn_s_barrier()
#define PG8_SCHED __builtin_amdgcn_sched_barrier(0)
    Unit cur, nxt; int ui = 0;
    if (!S.next(0, cur)) return;
    Acc acc; zero_acc(acc);
    bf16x8 At[4][2], B0[2][2], B1[2][2];
    const char* cA = (const char*)g.A + (size_t)cur.pm * tstepA; const char* cB = (const char*)g.Bt + (size_t)cur.pn * tstepB;
    PG8_STAGE(PG8_SB(0, 0), cB, voffB); PG8_STAGE(PG8_SA(0, 0), cA, voffA); PG8_STAGE(PG8_SB(0, 1), cB + hstepB, voffB); PG8_STAGE(PG8_SA(0, 1), cA + hstepA, voffA);
    if (wr == 1) PG8_BAR;
    PG8_WAIT_V(4); PG8_BAR;
    PG8_STAGE(PG8_SB(1, 0), cB + kstep, voffB); PG8_STAGE(PG8_SA(1, 0), cA + kstep, voffA); PG8_STAGE(PG8_SB(1, 1), cB + hstepB + kstep, voffB);
    PG8_WAIT_V(6); PG8_BAR;
    for (;;) {
        const bool has_next = S.next(ui + 1, nxt);
        const char* nA = has_next ? (const char*)g.A + (size_t)nxt.pm * tstepA : cA; const char* nB = has_next ? (const char*)g.Bt + (size_t)nxt.pn * tstepB : cB;
        for (int t = 0; t < nt; t += 2) {
            const bool last = (t == nt - 2);
            const char* a1 = cA + (size_t)(t + 1) * kstep;
            const char* a2 = last ? nA : cA + (size_t)(t + 2) * kstep; const char* b2 = last ? nB : cB + (size_t)(t + 2) * kstep;
            const char* a3 = a2 + kstep; const char* b3 = b2 + kstep;
            PG8_LDB(B0, 0, 0); PG8_SCHED; PG8_LDA(At, 0, 0); PG8_STAGE(PG8_SA(1, 1), a1 + hstepA, voffA);
            PG8_WAIT_L(8); PG8_BAR; PG8_WAIT_L(0); PG8_MMA(0, 0, At, B0); PG8_BAR; PG8_SCHED;
            PG8_LDB(B1, 0, 1); PG8_STAGE(PG8_SB(0, 0), b2, voffB);
            PG8_BAR; PG8_WAIT_L(0); PG8_MMA(0, 1, At, B1); PG8_BAR;
            PG8_LDA(At, 0, 1); PG8_STAGE(PG8_SA(0, 0), a2, voffA);
            PG8_BAR; PG8_WAIT_L(0); PG8_MMA(1, 0, At, B0); PG8_BAR; PG8_SCHED;
            PG8_STAGE(PG8_SB(0, 1), b2 + hstepB, voffB);
            PG8_WAIT_V(6); PG8_BAR; PG8_MMA(1, 1, At, B1); PG8_BAR;
            PG8_LDB(B0, 1, 0); PG8_SCHED; PG8_LDA(At, 1, 0); PG8_STAGE(PG8_SA(0, 1), a2 + hstepA, voffA);
            PG8_WAIT_L(8); PG8_BAR; PG8_WAIT_L(0); PG8_MMA(0, 0, At, B0); PG8_BAR; PG8_SCHED;
            PG8_LDB(B1, 1, 1); PG8_STAGE(PG8_SB(1, 0), b3, voffB);
            PG8_BAR; PG8_WAIT_L(0); PG8_MMA(0, 1, At, B1); PG8_BAR;
            PG8_LDA(At, 1, 1); PG8_STAGE(PG8_SA(1, 0), a3, voffA);
            PG8_BAR; PG8_WAIT_L(0); PG8_MMA(1, 0, At, B0); PG8_BAR; PG8_SCHED;
            PG8_STAGE(PG8_SB(1, 1), b3 + hstepB, voffB);
            PG8_WAIT_V(6); PG8_BAR; PG8_MMA(1, 1, At, B1); PG8_BAR;
        }
        E(acc, cur, wr, wc, fr, fq);
        if (!has_next) break;
        cur = nxt; cA = nA; cB = nB; ++ui;
    }
    PG8_WAIT_V(0);
    if (wr == 0) PG8_BAR;
    PG8_BAR;
#undef PG8_SA
#undef PG8_SB
#undef PG8_STAGE
#undef PG8_LDA
#undef PG8_LDB
#undef PG8_MMA
#undef PG8_WAIT_V
#undef PG8_WAIT_L
#undef PG8_BAR
#undef PG8_SCHED
}
}

__device__ void phase_prologue(const Params& p, LAS unsigned char* lds) {
    int tid_ = threadIdx.x; asm volatile("" : "+v"(tid_)); const int tid = tid_;
    for (int i = blockIdx.x * 512 + tid; i < SEQ * 32; i += gridDim.x * 512) {
        const int pos = i >> 5, fi = i & 31;
        const float invf = exp2f(-(float)fi * (13.287712379549449f / 32.0f));
        const float ang = (float)pos * invf;
        double rev = (double)ang * 0.15915494309189535;
        rev -= rint(rev);
        const float rf = (float)rev;
        p.rope[i] = make_float2(__builtin_amdgcn_cosf(rf), __builtin_amdgcn_sinf(rf));
    }
    if (blockIdx.x == 0) {
        const int i = tid;
        float lg[DEPTH], mx = -1e30f;
#pragma unroll
        for (int l = 0; l < DEPTH; ++l) { lg[l] = p.lb_logits[l * 512 + i]; mx = fmaxf(mx, lg[l]); }
        float s = 0.f;
#pragma unroll
        for (int l = 0; l < DEPTH; ++l) { lg[l] = expf(lg[l] - mx); s += lg[l]; }
        const float inv = 1.0f / s; const float p0 = lg[0] * inv; float cum = 0.f;
#pragma unroll
        for (int l = 0; l < DEPTH; ++l) { cum += lg[l] * inv; p.lb[l * 512 + i] = fmaxf(cum - p0, 0.0f); }
    }
    LAS float* cact = (LAS float*)lds;
    LAS float* red = (LAS float*)(lds + 65536);
    for (int item = blockIdx.x; item < DEPTH * 48; item += gridDim.x) {
        const int l = item / 48, cb = item % 48;
        for (int i = tid; i < BATCH * D; i += 512) { const float c = p.c[i]; cact[i] = c * sigmoidf_(c); }
        __syncthreads();
        const int col = tid & 127, kq = tid >> 7;
        float acc[16];
#pragma unroll
        for (int b = 0; b < 16; ++b) acc[b] = 0.f;
        const float* wp = p.w_ada + ((size_t)l * D + kq * 256) * (6 * D) + cb * 128 + col;
        for (int k = 0; k < 256; k += 4) {
            const float w0 = wp[(size_t)k * (6 * D)], w1 = wp[(size_t)(k + 1) * (6 * D)], w2 = wp[(size_t)(k + 2) * (6 * D)], w3 = wp[(size_t)(k + 3) * (6 * D)];
#pragma unroll
            for (int b = 0; b < 16; ++b) { const f32x4 cv = *(const LAS f32x4*)(cact + b * D + kq * 256 + k); acc[b] += cv[0] * w0 + cv[1] * w1 + cv[2] * w2 + cv[3] * w3; }
        }
#pragma unroll
        for (int b = 0; b < 16; ++b) red[(kq * 16 + b) * 128 + col] = acc[b];
        __syncthreads();
        for (int e = tid; e < 16 * 128; e += 512) {
            const int b = e >> 7, cc = e & 127;
            const float s = red[(0 * 16 + b) * 128 + cc] + red[(1 * 16 + b) * 128 + cc] + red[(2 * 16 + b) * 128 + cc] + red[(3 * 16 + b) * 128 + cc];
            p.mod[((size_t)l * BATCH + b) * (6 * D) + cb * 128 + cc] = s + p.b_ada[l * 6 * D + cb * 128 + cc];
        }
        __syncthreads();
    }
}

struct ConvTile { const float* src; int ldsrc; bf16_t* dst; int K; int k0; int n0; int kind; const float* wa; };
__device__ __forceinline__ int conv_srccol(int kind, int n) {
    if (kind == 1) return n < 5632 ? n : n < 8704 ? n + 32 : -2;
    if (kind == 2) { const int pn = n >> 8, bj = (n >> 7) & 1, ii = n & 127; return bj * DFF + pn * 128 + ii; }
    return n;
}
__device__ __forceinline__ ConvTile conv_decode(const Params& p, int l, int t) {
    constexpr int T_IN = 8 * 144, T_P = 3 * 4 * 16, T_OUT = 8 * 16, T_FI = 8 * 88;
    int i = t; ConvTile c;
    if (i < T_IN) { c = ConvTile{p.w_in + (size_t)l * D * NIN, NIN, p.wt_in, D, (i & 7) * 128, (i >> 3) * 64, 1, p.w_alpha + (size_t)l * 2 * 16 * 256}; return c; }
    i -= T_IN;
    if (i < T_P) { const int br = i / 64, r = i % 64;
        c = ConvTile{(br == 0 ? p.w_pa : br == 1 ? p.w_pb : p.w_pc) + (size_t)l * 512 * D, D, p.wt_p + (size_t)br * D * 512, 512, (r & 3) * 128, (r >> 2) * 64, 0, nullptr}; return c; }
    i -= T_P;
    if (i < T_OUT) { c = ConvTile{p.w_out + (size_t)l * D * D, D, p.wt_out, D, (i & 7) * 128, (i >> 3) * 64, 0, nullptr}; return c; }
    i -= T_OUT;
    if (i < T_FI) { c = ConvTile{p.w_ffn_in + (size_t)l * D * 2 * DFF, 2 * DFF, p.wt_fi, D, (i & 7) * 128, (i >> 3) * 64, 2, nullptr}; return c; }
    i -= T_FI;
    c = ConvTile{p.w_ffn_out + (size_t)l * DFF * D, D, p.wt_fo, DFF, (i % 22) * 128, (i / 22) * 64, 0, nullptr}; return c;
}
__device__ __forceinline__ void conv_load(const ConvTile& c, int tid, float (&v)[16]) {
    if (c.kind == 1 && c.n0 >= 8704) {
        const int cidx = tid & 63, fc = c.n0 + cidx - 8704, dr = fc >> 8, ch = fc & 255;
        float wa[16];
#pragma unroll
        for (int r = 0; r < 16; ++r) wa[r] = c.wa[(dr * 16 + r) * 256 + ch];
#pragma unroll
        for (int i = 0; i < 16; ++i) { const int r_ = (tid >> 6) + 8 * i; const float* sp = c.src + (size_t)(c.k0 + r_) * c.ldsrc + 5632 + dr * 16;
            float a = 0.f;
#pragma unroll
            for (int q = 0; q < 4; ++q) { const f32x4 t = *(const f32x4*)(sp + q * 4); a += t[0] * wa[q * 4] + t[1] * wa[q * 4 + 1] + t[2] * wa[q * 4 + 2] + t[3] * wa[q * 4 + 3]; }
            v[i] = a; }
        return;
    }
    const int col4 = (tid & 15) * 4; const int sc4 = conv_srccol(c.kind, c.n0 + col4);
#pragma unroll
    for (int i = 0; i < 4; ++i) { const int r = (tid >> 4) + 32 * i; const f32x4 t = *(const f32x4*)(c.src + (size_t)(c.k0 + r) * c.ldsrc + sc4);
        v[i * 4] = t[0]; v[i * 4 + 1] = t[1]; v[i * 4 + 2] = t[2]; v[i * 4 + 3] = t[3]; }
}
__device__ __forceinline__ void conv_to_lds(const ConvTile& c, int tid, LAS float* tile, const float (&v)[16]) {
    if (c.kind == 1 && c.n0 >= 8704) {
#pragma unroll
        for (int i = 0; i < 16; ++i) tile[((tid >> 6) + 8 * i) * 65 + (tid & 63)] = v[i];
    } else {
#pragma unroll
        for (int i = 0; i < 4; ++i)
#pragma unroll
            for (int j = 0; j < 4; ++j) tile[((tid >> 4) + 32 * i) * 65 + (tid & 15) * 4 + j] = v[i * 4 + j];
    }
}
__device__ void phase_conv(const Params& p, LAS unsigned char* lds, int l) {
    LAS float* tile = (LAS float*)lds;
    constexpr int TOT = 8 * 144 + 3 * 4 * 16 + 8 * 16 + 8 * 88 + 22 * 16;
    int tid_ = threadIdx.x; asm volatile("" : "+v"(tid_)); const int tid = tid_;
    int t = blockIdx.x;
    if (t >= TOT) return;
    ConvTile cur = conv_decode(p, l, t);
    float v[16]; conv_load(cur, tid, v);
    for (;;) {
        const int tn = t + gridDim.x; const bool has_next = tn < TOT;
        conv_to_lds(cur, tid, tile, v);
        ConvTile nxt = cur;
        if (has_next) { nxt = conv_decode(p, l, tn); conv_load(nxt, tid, v); }
        __syncthreads();
        {
            const int n = tid >> 3, kk = (tid & 7) * 16;
            float w[16];
#pragma unroll
            for (int j = 0; j < 16; ++j) w[j] = tile[(kk + j) * 65 + n];
            bf16_t* dp = cur.dst + (size_t)(cur.n0 + n) * cur.K + cur.k0 + kk;
            *(u32x4*)dp = (u32x4){cvt_pk_bf16(w[0], w[1]), cvt_pk_bf16(w[2], w[3]), cvt_pk_bf16(w[4], w[5]), cvt_pk_bf16(w[6], w[7])};
            *(u32x4*)(dp + 8) = (u32x4){cvt_pk_bf16(w[8], w[9]), cvt_pk_bf16(w[10], w[11]), cvt_pk_bf16(w[12], w[13]), cvt_pk_bf16(w[14], w[15])};
        }
        __syncthreads();
        if (!has_next) break;
        cur = nxt; t = tn;
    }
}

__device__ void phase_norm(const float* xg  , const float* gain, const float* modg  , int shoff, int scoff, bf16_t* h, int nrows) {
    int tid_ = threadIdx.x; asm volatile("" : "+v"(tid_));
    const int lane = tid_ & 63, wid = tid_ >> 6;
    for (int rg = blockIdx.x; rg < nrows / 16; rg += gridDim.x) {
        f32x4 v[2][4]; float ss[2] = {0.f, 0.f};
#pragma unroll
        for (int t = 0; t < 2; ++t) { const float* xr = xg + (size_t)(rg * 16 + t * 8 + wid) * D;
#pragma unroll
            for (int i = 0; i < 4; ++i) v[t][i] = *(const f32x4*)(xr + lane * 4 + i * 256); }
#pragma unroll
        for (int t = 0; t < 2; ++t) {
#pragma unroll
            for (int i = 0; i < 4; ++i) ss[t] += v[t][i][0] * v[t][i][0] + v[t][i][1] * v[t][i][1] + v[t][i][2] * v[t][i][2] + v[t][i][3] * v[t][i][3];
#pragma unroll
            for (int m = 32; m >= 1; m >>= 1) ss[t] += __shfl_xor(ss[t], m); }
#pragma unroll
        for (int t = 0; t < 2; ++t) {
            const int row = rg * 16 + t * 8 + wid; const float* mb = modg + (size_t)(row / SEQ) * (6 * D);
            const float rstd = rsqrtf(ss[t] * (1.0f / D) + 1e-6f);
#pragma unroll
            for (int i = 0; i < 4; ++i) { const int c = lane * 4 + i * 256;
                const f32x4 g = *(const f32x4*)(gain + c), sc = *(const f32x4*)(mb + scoff + c), sh = *(const f32x4*)(mb + shoff + c);
                float r[4];
#pragma unroll
                for (int j = 0; j < 4; ++j) r[j] = v[t][i][j] * rstd * g[j] * (1.0f + sc[j]) + sh[j];
                *(u32x2*)(h + (size_t)row * D + c) = (u32x2){cvt_pk_bf16(r[0], r[1]), cvt_pk_bf16(r[2], r[3])}; }
        }
    }
}
__device__ void phase_final(const Params& p) {
    int tid_ = threadIdx.x; asm volatile("" : "+v"(tid_));
    const int lane = tid_ & 63, wid = tid_ >> 6;
    f32x4 g[4];
#pragma unroll
    for (int i = 0; i < 4; ++i) g[i] = *(const f32x4*)(p.norm_f_g + lane * 4 + i * 256);
    for (int rg = blockIdx.x; rg < BATCH * SEQ / 16; rg += gridDim.x) {
        f32x4 v[2][4]; float ss[2];
#pragma unroll
        for (int t = 0; t < 2; ++t) { const float* xr = p.out + (size_t)(rg * 16 + t * 8 + wid) * D;
#pragma unroll
            for (int i = 0; i < 4; ++i) v[t][i] = *(const f32x4*)(xr + lane * 4 + i * 256); }
#pragma unroll
        for (int t = 0; t < 2; ++t) { ss[t] = 0.f;
#pragma unroll
            for (int i = 0; i < 4; ++i) ss[t] += v[t][i][0] * v[t][i][0] + v[t][i][1] * v[t][i][1] + v[t][i][2] * v[t][i][2] + v[t][i][3] * v[t][i][3];
#pragma unroll
            for (int m = 32; m >= 1; m >>= 1) ss[t] += __shfl_xor(ss[t], m); }
#pragma unroll
        for (int t = 0; t < 2; ++t) { float* xr = p.out + (size_t)(rg * 16 + t * 8 + wid) * D;
            const float rstd = rsqrtf(ss[t] * (1.0f / D) + 1e-6f);
#pragma unroll
            for (int i = 0; i < 4; ++i) *(f32x4*)(xr + lane * 4 + i * 256) = v[t][i] * rstd * g[i]; }
    }
}

template <int DK, int DV, int MIX>
__device__ void scan_item(const Params& p, LAS unsigned char* lds, int layer, int bl, int head, int dir, int vhalf) {
    constexpr int TG = 512 / DK, TPG = 64 / TG;
    constexpr int TGV = 512 / DV, TPGV = 64 / TGV;
    constexpr int SQ = DK * 2 + 16, S64 = 144;
    constexpr int OFF_QT = 0, OFF_KT = OFF_QT + 64 * SQ, OFF_QS = OFF_KT + 64 * SQ, OFF_KL = OFF_QS + 64 * SQ, OFF_VT = OFF_KL + DK * S64,
                  OFF_P = OFF_VT + DV * S64, OFF_ST = OFF_P + 64 * S64, OFF_TOT = OFF_ST + DV * SQ, OFF_EL = OFF_TOT + TG * DK * 4,
                  OFF_RQ = OFF_EL + DK * 4, OFF_RK = OFF_RQ + 64 * DK * 2, OFF_RV = OFF_RK + 64 * DK * 2, OFF_RL = OFF_RV + 64 * DV * 2, OFF_END = OFF_RL + (MIX == 2 ? 64 * 128 : 0);
    static_assert(OFF_END <= LDS_MAIN, "lds");
    static_assert(OFF_RQ % 1024 == 0 || true, "");
    constexpr int NV = DV / 32;
    int tid_ = threadIdx.x; asm volatile("" : "+v"(tid_));
    const int tid = tid_, lane = tid & 63, wid = __builtin_amdgcn_readfirstlane(tid >> 6), fr = lane & 15, fq = lane >> 4;
    const int d = tid % DK, g = tid / DK, vv = tid % DV, gv = tid / DV;
    const bf16_t* zb = p.z + (size_t)(bl * SEQ) * NZ;
    int cbq, cbk, cbv;
    if (MIX == 0) { cbq = ZA_Q + head * 128; cbk = (dir ? ZA_FB : ZA_FF) + head * 128; cbv = ZA_I + head * 128 + vhalf * 64; }
    else if (MIX == 1) { cbq = ZB_Q + head * 64; cbk = ZB_K + head * 64; cbv = ZB_V + head * 128; }
    else { cbq = ZC_Q + head * 64; cbk = ZC_K + head * 64; cbv = ZC_V + head * 128; }
    float lbv = 0.f, oml = 1.f, gam = 1.f, bal = 0.f;
    if (MIX == 0) { lbv = p.lb[layer * 512 + head * 128 + d]; oml = 1.0f - lbv; }
    if (MIX == 1) { const int hh = dir ? 3 - head : head; gam = 1.0f - exp2f(-5.0f - (float)hh); }
    if (MIX == 2) bal = p.b_alpha[((size_t)layer * 2 + dir) * 256 + head * 64 + d];
    const int cbl = ZC_LG + dir * 256 + head * 64;
    float2 rin[TPG];
    if (MIX == 1) {
#pragma unroll
        for (int tt = 0; tt < TPG; ++tt) { const int ip = g * TPG + tt; rin[tt] = p.rope[(dir ? 63 - ip : ip) * 32 + (d & 31)]; }
    }
    f32x4 S[4];
#pragma unroll
    for (int q = 0; q < 4; ++q) S[q] = (f32x4){0.f, 0.f, 0.f, 0.f};
    for (int i = tid * 16; i < DV * SQ; i += 512 * 16) *(LAS u32x4*)(lds + OFF_ST + i) = (u32x4){0u, 0u, 0u, 0u};
    const int ti = wid & 3;
    const int tj0 = (wid >> 2) * 2;
    const int tv0 = (wid >> 2) * NV;

    auto stage_rows = [&](int cn, int ldsoff, int colbase, int rbshift  ) {
        const int n = dir ? 31 - cn : cn;
        const bf16_t* zc = zb + (size_t)(n * 64) * NZ + colbase;
        const int rpw = 1024 >> rbshift, nwl = 64 / rpw, l16 = (1 << rbshift) >> 4;
        for (int wl = wid; wl < nwl; wl += 8) {
            const int row = wl * rpw + lane / l16, c16 = lane % l16; const int tk = dir ? 63 - row : row;
            __builtin_amdgcn_global_load_lds((const unsigned*)(zc + (size_t)tk * NZ + c16 * 8), (LAS unsigned*)(lds + ldsoff + wl * 1024), 16, 0, 0);
        }
    };
    constexpr int RBQ = (DK == 128) ? 8 : 7, RBV = (DV == 128) ? 8 : 7;
    stage_rows(0, OFF_RQ, cbq, RBQ); stage_rows(0, OFF_RK, cbk, RBQ); stage_rows(0, OFF_RV, cbv, RBV);
    if (MIX == 2) stage_rows(0, OFF_RL, cbl, 7);
    asm volatile("s_waitcnt vmcnt(0)" ::: "memory");
    __syncthreads();

    for (int cn = 0; cn < 32; ++cn) {
        const int n = dir ? 31 - cn : cn;
        float qv[TPG], kv[TPG], pl[TPG], sl[TPG];
        {
            float f[TPG];
            float2 rcs[TPG];
            if (MIX == 1) {
                const float2 cb = p.rope[(n * 64) * 32 + (d & 31)];
#pragma unroll
                for (int tt = 0; tt < TPG; ++tt) rcs[tt] = make_float2(cb.x * rin[tt].x - cb.y * rin[tt].y, cb.y * rin[tt].x + cb.x * rin[tt].y);
            }
#pragma unroll
            for (int tt = 0; tt < TPG; ++tt) {
                const int ip = g * TPG + tt;
                if (MIX == 0) {
                    qv[tt] = bf2f(*(const LAS bf16_t*)(lds + OFF_RQ + ip * (DK * 2) + d * 2));
                    const float sg = bf2f(*(const LAS bf16_t*)(lds + OFF_RK + ip * (DK * 2) + d * 2));
                    f[tt] = fmaxf(lbv + oml * sg, 1e-30f); kv[tt] = oml * (1.0f - sg);
                } else if (MIX == 1) {
                    const int dl = d & 31;
                    const float q1 = bf2f(*(const LAS bf16_t*)(lds + OFF_RQ + ip * (DK * 2) + dl * 2)), q2 = bf2f(*(const LAS bf16_t*)(lds + OFF_RQ + ip * (DK * 2) + dl * 2 + 64));
                    const float k1 = bf2f(*(const LAS bf16_t*)(lds + OFF_RK + ip * (DK * 2) + dl * 2)), k2 = bf2f(*(const LAS bf16_t*)(lds + OFF_RK + ip * (DK * 2) + dl * 2 + 64));
                    const float2 cs = rcs[tt];
                    if (d < 32) { qv[tt] = q1 * cs.x - q2 * cs.y; kv[tt] = (k1 * cs.x - k2 * cs.y) * 0.125f; }
                    else        { qv[tt] = q1 * cs.y + q2 * cs.x; kv[tt] = (k1 * cs.y + k2 * cs.x) * 0.125f; }
                    f[tt] = gam;
                } else {
                    qv[tt] = bf2f(*(const LAS bf16_t*)(lds + OFF_RQ + ip * (DK * 2) + d * 2)) * 0.125f; kv[tt] = bf2f(*(const LAS bf16_t*)(lds + OFF_RK + ip * (DK * 2) + d * 2));
                    const float logit = bal + bf2f(*(const LAS bf16_t*)(lds + OFF_RL + ip * 128 + d * 2));
                    const float lg = (fminf(logit, 0.f) - __logf(1.0f + __expf(-fabsf(logit)))) * (1.0f / 16.0f);
                    f[tt] = __expf(lg);
                }
            }
            pl[0] = f[0];
#pragma unroll
            for (int tt = 1; tt < TPG; ++tt) pl[tt] = pl[tt - 1] * f[tt];
            sl[TPG - 1] = 1.0f;
#pragma unroll
            for (int tt = TPG - 2; tt >= 0; --tt) sl[tt] = sl[tt + 1] * f[tt + 1];
        }
        ((LAS float*)(lds + OFF_TOT))[g * DK + d] = pl[TPG - 1];
        __syncthreads();
        if (cn + 1 < 32) { stage_rows(cn + 1, OFF_RQ, cbq, RBQ); stage_rows(cn + 1, OFF_RK, cbk, RBQ); if (MIX == 2) stage_rows(cn + 1, OFF_RL, cbl, 7); }
        {
            unsigned vp[TPGV / 2];
#pragma unroll
            for (int tt = 0; tt < TPGV; tt += 2) { const int ip = gv * TPGV + tt;
                vp[tt >> 1] = (unsigned)*(const LAS bf16_t*)(lds + OFF_RV + ip * (DV * 2) + vv * 2) | ((unsigned)*(const LAS bf16_t*)(lds + OFF_RV + (ip + 1) * (DV * 2) + vv * 2) << 16); }
            float H1 = 1.f, H2 = 1.f, R = 1.f, Fh = 1.f, Gl = 1.f, Gh = 1.f;
#pragma unroll
            for (int gg = 0; gg < TG; ++gg) { const float t = ((LAS float*)(lds + OFF_TOT))[gg * DK + d];
                if (gg < TG / 2) { H1 *= t; if (gg >= g) R *= t; if (gg > g) Gl *= t; }
                else { H2 *= t; if (gg < g) Fh *= t; if (gg > g) Gh *= t; } }
            const float Fg = (g < TG / 2) ? __builtin_amdgcn_rcpf(fmaxf(R, 1e-30f)) : Fh;
            const float Gg = (g < TG / 2) ? Gl : Gh * __builtin_amdgcn_rcpf(fmaxf(H2, 1e-30f));
            if (g == 0) ((LAS float*)(lds + OFF_EL))[d] = H1 * H2;
            unsigned klp[TPG / 2];
#pragma unroll
            for (int tt = 0; tt < TPG; tt += 2) {
                const int ip = g * TPG + tt;
                const float qa = qv[tt] * (pl[tt] * Fg), qb = qv[tt + 1] * (pl[tt + 1] * Fg);
                const float ka = kv[tt] * (sl[tt] * Gg), kb = kv[tt + 1] * (sl[tt + 1] * Gg);
                const unsigned wq = cvt_pk_bf16(qa, qb), wk = cvt_pk_bf16(ka, kb), ws = cvt_pk_bf16(qa * H1, qb * H1);
                *(LAS bf16_t*)(lds + OFF_QT + ip * SQ + d * 2) = (bf16_t)wq; *(LAS bf16_t*)(lds + OFF_QT + (ip + 1) * SQ + d * 2) = (bf16_t)(wq >> 16);
                *(LAS bf16_t*)(lds + OFF_KT + ip * SQ + d * 2) = (bf16_t)wk; *(LAS bf16_t*)(lds + OFF_KT + (ip + 1) * SQ + d * 2) = (bf16_t)(wk >> 16);
                *(LAS bf16_t*)(lds + OFF_QS + ip * SQ + d * 2) = (bf16_t)ws; *(LAS bf16_t*)(lds + OFF_QS + (ip + 1) * SQ + d * 2) = (bf16_t)(ws >> 16);
                klp[tt >> 1] = cvt_pk_bf16(ka * H2, kb * H2);
            }
#pragma unroll
            for (int q = 0; q < TPG / 8; ++q) *(LAS u32x4*)(lds + OFF_KL + d * S64 + (g * TPG + q * 8) * 2) = (u32x4){klp[q * 4], klp[q * 4 + 1], klp[q * 4 + 2], klp[q * 4 + 3]};
#pragma unroll
            for (int q = 0; q < TPGV / 8; ++q) *(LAS u32x4*)(lds + OFF_VT + vv * S64 + (gv * TPGV + q * 8) * 2) = (u32x4){vp[q * 4], vp[q * 4 + 1], vp[q * 4 + 2], vp[q * 4 + 3]};
        }
        __syncthreads();
        if (cn + 1 < 32) stage_rows(cn + 1, OFF_RV, cbv, RBV);
        f32x4 oa[NV];
        {
            f32x4 sc[2] = {(f32x4){0.f, 0.f, 0.f, 0.f}, (f32x4){0.f, 0.f, 0.f, 0.f}};
#pragma unroll
            for (int q = 0; q < NV; ++q) oa[q] = (f32x4){0.f, 0.f, 0.f, 0.f};
#pragma unroll
            for (int ks = 0; ks < DK / 32; ++ks) {
                const bf16x8 bq = *(const LAS bf16x8*)(lds + OFF_QT + (ti * 16 + fr) * SQ + ks * 64 + fq * 16);
#pragma unroll
                for (int jj = 0; jj < 2; ++jj) { const bf16x8 ak = *(const LAS bf16x8*)(lds + OFF_KT + ((tj0 + jj) * 16 + fr) * SQ + ks * 64 + fq * 16);
                    sc[jj] = __builtin_amdgcn_mfma_f32_16x16x32_bf16(ak, bq, sc[jj], 0, 0, 0); }
                const bf16x8 bs = *(const LAS bf16x8*)(lds + OFF_QS + (ti * 16 + fr) * SQ + ks * 64 + fq * 16);
#pragma unroll
                for (int q = 0; q < NV; ++q) { const bf16x8 as = *(const LAS bf16x8*)(lds + OFF_ST + ((tv0 + q) * 16 + fr) * SQ + ks * 64 + fq * 16);
                    oa[q] = __builtin_amdgcn_mfma_f32_16x16x32_bf16(as, bs, oa[q], 0, 0, 0); }
            }
            const int ipc = ti * 16 + fr;
#pragma unroll
            for (int jj = 0; jj < 2; ++jj) { const int jp0 = (tj0 + jj) * 16 + fq * 4; float m[4];
#pragma unroll
                for (int r = 0; r < 4; ++r) { const int jp = jp0 + r; const bool keep = dir ? (jp < ipc) : (jp <= ipc); m[r] = keep ? sc[jj][r] : 0.f; }
                *(LAS u32x2*)(lds + OFF_P + ipc * S64 + jp0 * 2) = (u32x2){cvt_pk_bf16(m[0], m[1]), cvt_pk_bf16(m[2], m[3])}; }
        }
        asm volatile("s_waitcnt vmcnt(0)" ::: "memory");
        __syncthreads();
        {
#pragma unroll
            for (int ks = 0; ks < 2; ++ks) {
                const bf16x8 bp = *(const LAS bf16x8*)(lds + OFF_P + (ti * 16 + fr) * S64 + ks * 64 + fq * 16);
#pragma unroll
                for (int q = 0; q < NV; ++q) { const bf16x8 av = *(const LAS bf16x8*)(lds + OFF_VT + ((tv0 + q) * 16 + fr) * S64 + ks * 64 + fq * 16);
                    oa[q] = __builtin_amdgcn_mfma_f32_16x16x32_bf16(av, bp, oa[q], 0, 0, 0); }
            }
            const int ip = ti * 16 + fr; const int tk = dir ? 63 - ip : ip;
            bf16_t* op = p.o + ((size_t)(dir * 3 + MIX) * MH + bl * SEQ + n * 64 + tk) * 512 + head * 128 + vhalf * 64;
#pragma unroll
            for (int q = 0; q < NV; ++q) *(u32x2*)(op + (tv0 + q) * 16 + fq * 4) = (u32x2){cvt_pk_bf16(oa[q][0], oa[q][1]), cvt_pk_bf16(oa[q][2], oa[q][3])};
        }
#pragma unroll
        for (int q = 0; q < 4; ++q) {
            const int tix = wid * 4 + q, td = tix / (DV / 16), tv = tix % (DV / 16);
            const f32x4 el = *(const LAS f32x4*)(lds + OFF_EL + (td * 16 + fq * 4) * 4);
            S[q] *= el;
#pragma unroll
            for (int ks = 0; ks < 2; ++ks) {
                const bf16x8 ak = *(const LAS bf16x8*)(lds + OFF_KL + (td * 16 + fr) * S64 + ks * 64 + fq * 16);
                const bf16x8 bv = *(const LAS bf16x8*)(lds + OFF_VT + (tv * 16 + fr) * S64 + ks * 64 + fq * 16);
                S[q] = __builtin_amdgcn_mfma_f32_16x16x32_bf16(ak, bv, S[q], 0, 0, 0);
            }
            *(LAS u32x2*)(lds + OFF_ST + (tv * 16 + fr) * SQ + (td * 16 + fq * 4) * 2) = (u32x2){cvt_pk_bf16(S[q][0], S[q][1]), cvt_pk_bf16(S[q][2], S[q][3])};
        }
    }
    asm volatile("s_waitcnt vmcnt(0)" ::: "memory");
    __syncthreads();
}
__device__ void phase_scan(const Params& p, LAS unsigned char* lds, int layer) {
    for (int item = blockIdx.x; item < 256; item += gridDim.x) {
        if (item < 128) { const int vhalf = item & 1, dir = (item >> 1) & 1, head = (item >> 2) & 3, bl = item >> 4; scan_item<128, 64, 0>(p, lds, layer, bl, head, dir, vhalf); }
        else if (item < 192) { const int i = item - 128, dir = i & 1, head = (i >> 1) & 3, bl = i >> 3; scan_item<64, 128, 1>(p, lds, layer, bl, head, dir, 0); }
        else { const int i = item - 192, dir = i & 1, head = (i >> 1) & 3, bl = i >> 3; scan_item<64, 128, 2>(p, lds, layer, bl, head, dir, 0); }
    }
}

__device__ void phase_ypass(const Params& p, int layer) {
    int tid_ = threadIdx.x; asm volatile("" : "+v"(tid_));
    const int lane = tid_ & 63, wid = tid_ >> 6;
    const int ch = (lane >> 4) * 128 + (lane & 15) * 8;
    f32x4 gn[3][2];
#pragma unroll
    for (int br = 0; br < 3; ++br) { const float* g = (br == 0 ? p.norm_a_g : br == 1 ? p.norm_b_g : p.norm_c_g) + layer * 512 + ch; gn[br][0] = *(const f32x4*)g; gn[br][1] = *(const f32x4*)(g + 4); }
    for (int rg = blockIdx.x; rg < MH / 16; rg += gridDim.x) {
        u32x4 a[2][3], b[2][3], gz[2][3];
#pragma unroll
        for (int t = 0; t < 2; ++t) { const int tok = rg * 16 + t * 8 + wid; const bf16_t* zr = p.z + (size_t)tok * NZ;
#pragma unroll
            for (int br = 0; br < 3; ++br) {
                a[t][br] = *(const u32x4*)(p.o + ((size_t)br * MH + tok) * 512 + ch);
                b[t][br] = *(const u32x4*)(p.o + ((size_t)(3 + br) * MH + tok) * 512 + ch);
                gz[t][br] = *(const u32x4*)(zr + (br == 0 ? ZA_G : br == 1 ? ZB_G : ZC_G) + ch); } }
#pragma unroll
        for (int t = 0; t < 2; ++t) { const int tok = rg * 16 + t * 8 + wid;
#pragma unroll
            for (int br = 0; br < 3; ++br) {
                float s[8], gt[8];
#pragma unroll
                for (int e = 0; e < 4; ++e) {
                    s[2 * e] = __uint_as_float(a[t][br][e] << 16) + __uint_as_float(b[t][br][e] << 16);
                    s[2 * e + 1] = __uint_as_float(a[t][br][e] & 0xffff0000u) + __uint_as_float(b[t][br][e] & 0xffff0000u);
                    gt[2 * e] = __uint_as_float(gz[t][br][e] << 16); gt[2 * e + 1] = __uint_as_float(gz[t][br][e] & 0xffff0000u); }
                float mu = 0.f;
                if (br == 1) {
#pragma unroll
                    for (int j = 0; j < 8; ++j) mu += s[j];
#pragma unroll
                    for (int m = 8; m >= 1; m >>= 1) mu += __shfl_xor(mu, m);
                    mu *= (1.0f / 128.0f);
                }
                float ss = 0.f;
#pragma unroll
                for (int j = 0; j < 8; ++j) { s[j] -= mu; ss += s[j] * s[j]; }
#pragma unroll
                for (int m = 8; m >= 1; m >>= 1) ss += __shfl_xor(ss, m);
                const float rstd = rsqrtf(ss * (1.0f / 128.0f) + 1e-6f);
                float r[8];
#pragma unroll
                for (int j = 0; j < 8; ++j) { const float gn_ = gn[br][j >> 2][j & 3]; const float sg = sigmoidf_(gt[j]);
                    const float act = br == 0 ? sg : gt[j] * sg; r[j] = s[j] * rstd * gn_ * act; }
                *(u32x4*)(p.o + ((size_t)br * MH + tok) * 512 + ch) = (u32x4){cvt_pk_bf16(r[0], r[1]), cvt_pk_bf16(r[2], r[3]), cvt_pk_bf16(r[4], r[5]), cvt_pk_bf16(r[6], r[7])};
            } }
    }
}

#define XB_TMO      128
#define XB_XCNT(j)  (256  + 64 * (j))
#define XB_XSUB(j)  (1280 + 64 * (j))
#define XB_XGEN(j)  (2304 + 64 * (j))
#define XB_TOP      3328
#define XB_TOPGEN   3392
#define XCD_BAR_WORDS 3456
#define XB_SPIN_CAP (1u << 22)
__device__ __forceinline__ unsigned xb_ld(unsigned* p)              { return __hip_atomic_load(p, __ATOMIC_RELAXED, __HIP_MEMORY_SCOPE_AGENT); }
__device__ __forceinline__ unsigned xb_add(unsigned* p, unsigned v) { return __hip_atomic_fetch_add(p, v, __ATOMIC_RELAXED, __HIP_MEMORY_SCOPE_AGENT); }
__device__ __forceinline__ unsigned xb_xcc_id() { return (unsigned)__builtin_amdgcn_s_getreg((3 << 11) | 20) & 0xFu; }
#define XB_SPIN(cond, bar) do { unsigned _sp = 0; while (cond) { __builtin_amdgcn_s_sleep(1); \
    if ((++_sp & 255u) == 0u) { if (xb_ld(&(bar)[XB_TMO])) break; if (_sp > XB_SPIN_CAP) { atomicAdd(&(bar)[XB_TMO], 1u); break; } } } } while (0)
struct XcdBarrier { unsigned* bar; unsigned x; volatile LAS unsigned* st; };
__device__ __forceinline__ XcdBarrier xcd_barrier_post(unsigned* bar, volatile LAS unsigned* st) {
    XcdBarrier b; b.bar = bar; b.x = xb_xcc_id(); b.st = st;
    if (threadIdx.x == 0) (void)xb_add(&bar[XB_XCNT(b.x)], 1u);
    return b;
}
__device__ __forceinline__ void xcd_barrier_complete(unsigned* bar, unsigned x, unsigned& nloc, unsigned& nx) {
    const unsigned G = gridDim.x * gridDim.y * gridDim.z;
    unsigned sum, cnt, mine, sp = 0u;
    for (;;) {
        sum = 0u; cnt = 0u; mine = 0u;
#pragma unroll
        for (unsigned j = 0; j < 16; ++j) { const unsigned c = xb_ld(&bar[XB_XCNT(j)]); sum += c; cnt += (c > 0u) ? 1u : 0u; mine = (j == x) ? c : mine; }
        if (sum == G) break;
        __builtin_amdgcn_s_sleep(1);
        if ((++sp & 255u) == 0u) { if (xb_ld(&bar[XB_TMO])) break; if (sp > XB_SPIN_CAP) { atomicAdd(&bar[XB_TMO], 1u); break; } }
    }
    nloc = mine > 0u ? mine : 1u; nx = cnt > 0u ? cnt : 1u;
}
__device__ __forceinline__ void xcd_barrier(const XcdBarrier& b) {
    asm volatile("s_waitcnt vmcnt(0)" ::: "memory");
    __syncthreads();
    if (threadIdx.x == 0) {
        unsigned* bar = b.bar;
        __builtin_amdgcn_s_waitcnt(0);
        unsigned nloc = b.st[0], nx = b.st[1];
        if (nloc == 0u) { xcd_barrier_complete(bar, b.x, nloc, nx); b.st[0] = nloc; b.st[1] = nx; }
        const unsigned old = xb_add(&bar[XB_XSUB(b.x)], 1u);
        const unsigned gen = old / nloc;
        if (old + 1u == (gen + 1u) * nloc) {
            __builtin_amdgcn_fence(__ATOMIC_RELEASE, "agent");
            asm volatile("s_waitcnt vmcnt(0)" ::: "memory");
            const unsigned og = xb_add(&bar[XB_TOP], 1u);
            const unsigned tg = og / nx;
            if (og + 1u == (tg + 1u) * nx) xb_add(&bar[XB_TOPGEN], 1u);
            else XB_SPIN(xb_ld(&bar[XB_TOPGEN]) == tg, bar);
            __builtin_amdgcn_fence(__ATOMIC_ACQUIRE, "agent");
            xb_add(&bar[XB_XGEN(b.x)], 1u);
            asm volatile("s_waitcnt vmcnt(0)" ::: "memory");
        } else {
            XB_SPIN(xb_ld(&bar[XB_XGEN(b.x)]) == gen, bar);
            __builtin_amdgcn_fence(__ATOMIC_ACQUIRE, "agent");
            asm volatile("s_waitcnt vmcnt(0)" ::: "memory");
        }
    }
    __syncthreads();
}

constexpr int N_PHASES = 1 + DEPTH * (1 + 1 + NGRP * 4 + 3) + 1;

__global__ void __launch_bounds__(512, 2) mega(Params p, int ph0, int ph1) {
    extern __shared__ __attribute__((aligned(16))) unsigned char shm[];
    LAS unsigned char* lds = (LAS unsigned char*)shm;
    cg::grid_group grid = cg::this_grid();
    volatile LAS unsigned* xst = (volatile LAS unsigned*)(lds + LDS_MAIN);
    if (threadIdx.x == 0) { xst[0] = 0u; xst[1] = 0u; }
    __syncthreads();
    const XcdBarrier xb = xcd_barrier_post(p.bar, xst);
    int pc = 0;
#define PHASE_BEGIN if (pc >= ph0 && pc < ph1) {
#define PHASE_END   if (pc + 1 < ph1) { if (ph1 < 0) grid.sync(); else xcd_barrier(xb); } } ++pc;
    PHASE_BEGIN
        phase_prologue(p, lds);
        phase_conv(p, lds, 0);
    PHASE_END
    for (int l = 0; l < DEPTH; ++l) {
        const float* modL = p.mod + (size_t)l * BATCH * (6 * D);
        const float* xinL = (l == 0 ? p.x : p.out);
        PHASE_BEGIN
            if (l > 0) phase_conv(p, lds, l);
            phase_norm(xinL, p.norm1_g + l * D, modL, 0, D, p.h, 2 * MH);
        PHASE_END
        for (int grp = 0; grp < NGRP; ++grp) {
            const float* modg = modL + (size_t)grp * GB * (6 * D);
            float* xg = p.out + (size_t)grp * MH * D;
            const float* xin0 = xinL + (size_t)grp * MH * D;
            bf16_t* hg = p.h + (size_t)grp * MH * D;
            if (grp == 0) {
            PHASE_BEGIN
                pg8::Gemm g{hg, p.wt_in, D, D, D}; pg8::ProjOrder S; S.base.init(MH, NZ, gridDim.x, blockIdx.x);
                pg8::EpiZ E{p.z, NZ}; pg8::gemm_phase(lds, g, S, E);
            PHASE_END
            }
            PHASE_BEGIN
                phase_scan(p, lds, l);
            PHASE_END
            PHASE_BEGIN
                phase_ypass(p, l);
            PHASE_END
            PHASE_BEGIN
                pg8::Gemm g{p.o, p.wt_p, 512, 512, 512}; pg8::MergeOrder S; S.base.init(MH, D, gridDim.x, blockIdx.x);
                pg8::EpiMerge E{p.z, hg}; pg8::gemm_phase(lds, g, S, E);
            PHASE_END
            PHASE_BEGIN
                { pg8::Gemm g{hg, p.wt_out, D, D, D}; pg8::StaticOrder S; S.init(MH, D, gridDim.x, blockIdx.x);
                  pg8::EpiRes E{xin0, xg, modg + 2 * D}; pg8::gemm_phase(lds, g, S, E); }
                if (grp == 0) {
                    pg8::Gemm g{p.h + (size_t)MH * D, p.wt_in, D, D, D}; pg8::ProjOrder S; S.base.init(MH, NZ, gridDim.x, blockIdx.x);
                    pg8::EpiZ E{p.z, NZ}; pg8::gemm_phase(lds, g, S, E);
                }
            PHASE_END
        }
        {
            const float* modl = p.mod + (size_t)l * BATCH * (6 * D);
            PHASE_BEGIN
                phase_norm(p.out, p.norm2_g + l * D, modl, 3 * D, 4 * D, p.h2, 2 * MH);
            PHASE_END
            PHASE_BEGIN
                pg8::Gemm g{p.h2, p.wt_fi, D, D, D}; pg8::StaticOrder S; S.init(2 * MH, 2 * DFF, gridDim.x, blockIdx.x);
                pg8::EpiAct E{p.z, DFF}; pg8::gemm_phase(lds, g, S, E);
            PHASE_END
            PHASE_BEGIN
                pg8::Gemm g{p.z, p.wt_fo, DFF, DFF, DFF}; pg8::StaticOrder S; S.init(2 * MH, D, gridDim.x, blockIdx.x);
                pg8::EpiRes E{p.out, p.out, modl + 5 * D}; pg8::gemm_phase(lds, g, S, E);
            PHASE_END
        }
    }
    PHASE_BEGIN
        phase_final(p);
    PHASE_END
}

extern "C" void kernel_launch(void* const* d_in, const int* in_sizes, int n_in, void* d_out, int out_size, void* d_ws, size_t ws_size, hipStream_t stream) {
    Params p{};
    const float** f = (const float**)&p;
    for (int i = 0; i < 20; ++i) f[i] = (const float*)d_in[i];
    p.out = (float*)d_out;
    char* w = (char*)d_ws; size_t off = 0;
    auto take = [&](size_t bytes) { char* r = w + off; off += (bytes + 255) & ~(size_t)255; return r; };
    p.wt_in = (bf16_t*)take((size_t)NZ * D * 2);
    p.wt_p = (bf16_t*)take((size_t)3 * D * 512 * 2);
    p.wt_out = (bf16_t*)take((size_t)D * D * 2);
    p.wt_fi = (bf16_t*)take((size_t)2 * DFF * D * 2);
    p.wt_fo = (bf16_t*)take((size_t)D * DFF * 2);
    p.mod = (float*)take((size_t)DEPTH * BATCH * 6 * D * 4);
    p.lb = (float*)take((size_t)DEPTH * 512 * 4);
    p.rope = (float2*)take((size_t)SEQ * 32 * 8);
    p.h = (bf16_t*)take((size_t)2 * MH * D * 2);
    p.h2 = p.h;
    p.z = (bf16_t*)take((size_t)MH * NZ * 2);
    p.o = (bf16_t*)take((size_t)2 * 3 * MH * 512 * 2);
    p.bar = (unsigned*)take((size_t)XCD_BAR_WORDS * 4);
    if (off > ws_size) { fprintf(stderr, "workspace too small: need %zu have %zu\n", off, ws_size); return; }
    static int grid_blocks = 0;
    if (!grid_blocks) {
        (void)hipFuncSetAttribute((const void*)mega, hipFuncAttributeMaxDynamicSharedMemorySize, LDS_BYTES);
        int dev = 0, cus = 0, per_cu = 0;
        (void)hipGetDevice(&dev);
        (void)hipDeviceGetAttribute(&cus, hipDeviceAttributeMultiprocessorCount, dev);
        (void)hipOccupancyMaxActiveBlocksPerMultiprocessor(&per_cu, mega, 512, LDS_BYTES);
        if (per_cu < 1) per_cu = 1;
        grid_blocks = cus * 1;
    }
    (void)hipMemsetAsync(p.bar, 0, (size_t)XCD_BAR_WORDS * 4, stream);
#if MULTI_LAUNCH
    for (int ph = 0; ph < N_PHASES; ++ph)
        hipLaunchKernelGGL(mega, dim3(grid_blocks), dim3(512), LDS_BYTES, stream, p, ph, ph + 1);
#else
    int ph0 = 0, ph1 = N_PHASES;
    void* args[] = {&p, &ph0, &ph1};
    hipError_t e = hipLaunchCooperativeKernel((void*)mega, dim3(grid_blocks), dim3(512), args, LDS_BYTES, stream);
    if (e != hipSuccess) fprintf(stderr, "cooperative launch failed: %s (grid %d)\n", hipGetErrorString(e), grid_blocks);
#endif
}
```

```cpp
#include <hip/hip_runtime.h>
#include <hip/hip_cooperative_groups.h>
#include <cstdio>
namespace cg = cooperative_groups;

#ifndef MULTI_LAUNCH
#define MULTI_LAUNCH 0
#endif

#define LAS __attribute__((address_space(3)))
typedef unsigned short bf16_t;
typedef short bf16x8 __attribute__((ext_vector_type(8)));
typedef float f32x4 __attribute__((ext_vector_type(4)));
typedef unsigned u32x4 __attribute__((ext_vector_type(4)));
typedef unsigned u32x2 __attribute__((ext_vector_type(2)));

constexpr int D = 1024, BATCH = 16, SEQ = 2048, DEPTH = 4;
constexpr int GB = 8;
constexpr int NGRP = BATCH / GB;
constexpr int MH = GB * SEQ;
constexpr int NIN = 8736, NZ = 9216, DFF = 2816;
constexpr int LDS_MAIN = 155648;
constexpr int LDS_BYTES = LDS_MAIN + 16;
constexpr int ZA_Q = 0, ZA_FF = 512, ZA_FB = 1024, ZA_I = 1536, ZA_G = 2048;
constexpr int ZB_Q = 2560, ZB_K = 2816, ZB_V = 3072, ZB_G = 3584;
constexpr int ZC_Q = 4096, ZC_K = 4352, ZC_V = 4608, ZC_G = 5120, ZC_LG = 8704;
constexpr int ZG_A = 5632;

struct Params {
    const float *x, *c, *norm1_g, *w_ada, *b_ada, *w_in, *lb_logits, *norm_a_g, *norm_b_g, *norm_c_g, *w_alpha, *b_alpha,
                *w_pa, *w_pb, *w_pc, *w_out, *norm2_g, *w_ffn_in, *w_ffn_out, *norm_f_g;
    float* out;
    bf16_t *wt_in;
    bf16_t *wt_p;
    bf16_t *wt_out;
    bf16_t *wt_fi;
    bf16_t *wt_fo;
    float *mod;
    float *lb;
    float2 *rope;
    bf16_t *h;
    bf16_t *h2;
    bf16_t *z;
    bf16_t *o;
    unsigned *bar;
};

__device__ __forceinline__ float bf2f(bf16_t h) { return __uint_as_float(((unsigned)h) << 16); }
__device__ __forceinline__ bf16_t f2bf(float f) { unsigned u = __float_as_uint(f); u += 0x7fffu + ((u >> 16) & 1u); return (bf16_t)(u >> 16); }
__device__ __forceinline__ unsigned pk2(float lo, float hi) { return (unsigned)f2bf(lo) | ((unsigned)f2bf(hi) << 16); }
typedef __bf16 bf16x2_t __attribute__((ext_vector_type(2)));
typedef float f32x2_t __attribute__((ext_vector_type(2)));
__device__ __forceinline__ unsigned cvt_pk_bf16(float lo, float hi) { const f32x2_t f = {lo, hi}; const bf16x2_t v = __builtin_convertvector(f, bf16x2_t); return __builtin_bit_cast(unsigned, v); }
__device__ __forceinline__ float sigmoidf_(float x) { return __builtin_amdgcn_rcpf(1.0f + __expf(-x)); }
__device__ __forceinline__ f32x2_t sigmoid2(f32x2_t x) {
    const f32x2_t t = x * (-1.4426950408889634f); f32x2_t e; e[0] = __builtin_amdgcn_exp2f(t[0]); e[1] = __builtin_amdgcn_exp2f(t[1]);
    const f32x2_t d = e + 1.0f; f32x2_t r; r[0] = __builtin_amdgcn_rcpf(d[0]); r[1] = __builtin_amdgcn_rcpf(d[1]); return r;
}
__device__ __forceinline__ float clampf(float x, float lo, float hi) { return fminf(fmaxf(x, lo), hi); }

namespace pg8 {
constexpr int BM = 256, BK = 64, HALF = 128, HTB = HALF * BK * 2, STAGE_BYTES = 8 * HTB, NXCD = 8, WGM = 8;
__host__ __device__ __forceinline__ int lds_byte(int r, int c) { const int st = (r >> 4) * 2 + (c >> 5), rr = r & 15, cc = c & 31, ob = rr * 64 + cc * 2; return st * 1024 + (ob ^ (((ob >> 9) & 1) << 5)); }
__host__ __device__ __forceinline__ void stage_rc(int b, int& R, int& C) { const int st = b / 1024, sb = b % 1024, swz = sb ^ (((sb >> 9) & 1) << 5); R = (st >> 1) * 16 + swz / 64; C = (st & 1) * 32 + (swz % 64) / 2; }
__host__ __device__ __forceinline__ int perm32(int rho) { const int n = rho >> 4, i = rho & 15; return 8 * (i >> 2) + 4 * n + (i & 3); }

struct Unit { int pm, pn; };
struct Gemm { const bf16_t* A; const bf16_t* Bt; int lda, ldb, K; };

struct StaticOrder {
    int nM, nN, nwg, G, c;
    __device__ void init(int M, int N, int G_, int c_) { nM = M / BM; nN = N / BM; nwg = nM * nN; G = G_; c = c_; }
    __device__ bool next(int i, Unit& u) const {
        const long L = (long)i * G + c; if (L >= nwg) return false;
        int wgid = (int)L; { const int q = nwg / NXCD, r = nwg % NXCD, xcd = wgid % NXCD, off = wgid / NXCD; wgid = (xcd < r ? xcd * (q + 1) : r * (q + 1) + (xcd - r) * q) + off; }
        const int nig = WGM * nN, gid = wgid / nig, fm = gid * WGM, gsz = (nM - fm) < WGM ? (nM - fm) : WGM;
        u.pm = fm + ((wgid % nig) % gsz); u.pn = (wgid % nig) / gsz; return true;
    }
};
struct ProjOrder {
    StaticOrder base;
    __device__ bool next(int i, Unit& u) const { if (!base.next(i, u)) return false; u.pn = (u.pn + 22) % 36; return true; }
};
struct MergeOrder {
    StaticOrder base;
    __device__ bool next(int i, Unit& u) const { Unit t; if (!base.next(i / 3, t)) return false; const int br = i % 3; u.pm = br * (MH / BM) + t.pm; u.pn = br * (D / BM) + t.pn; return true; }
};

typedef f32x4 Acc[2][2][4][2];
__device__ __forceinline__ void zero_acc(Acc& acc) {
#pragma unroll
    for (int a = 0; a < 2; ++a)
#pragma unroll
        for (int b = 0; b < 2; ++b)
#pragma unroll
            for (int m = 0; m < 4; ++m)
#pragma unroll
                for (int n = 0; n < 2; ++n) acc[a][b][m][n] = (f32x4){0.f, 0.f, 0.f, 0.f};
}

struct EpiZ {
    static constexpr bool PERM = true;
    bf16_t* O; int ldc;
    __device__ __forceinline__ void operator()(Acc& acc, const Unit& u, int wr, int wc, int fr, int fq) const {
        const int row0 = u.pm * BM + wr * 64 + fr, col0 = u.pn * BM + wc * 32 + 8 * fq;
#pragma unroll
        for (int ai = 0; ai < 2; ++ai)
#pragma unroll
            for (int m = 0; m < 4; ++m) { bf16_t* rowp = O + (size_t)(row0 + ai * HALF + m * 16) * ldc + col0;
#pragma unroll
                for (int bj = 0; bj < 2; ++bj) { f32x4 v0 = acc[ai][bj][m][0], v1 = acc[ai][bj][m][1];
                    if (u.pn < 2) {
#pragma unroll
                        for (int j = 0; j < 4; j += 2) { const f32x2_t a = {v0[j], v0[j + 1]}, b = {v1[j], v1[j + 1]}; const f32x2_t sa = a * sigmoid2(a), sb = b * sigmoid2(b); v0[j] = sa[0]; v0[j + 1] = sa[1]; v1[j] = sb[0]; v1[j + 1] = sb[1]; } }
                    else if ((u.pn >= 2 && u.pn < 6) || (u.pn >= 22 && u.pn < 34)) {
#pragma unroll
                        for (int j = 0; j < 4; j += 2) { const f32x2_t a = {v0[j], v0[j + 1]}, b = {v1[j], v1[j + 1]}; const f32x2_t sa = sigmoid2(a), sb = sigmoid2(b); v0[j] = sa[0]; v0[j + 1] = sa[1]; v1[j] = sb[0]; v1[j + 1] = sb[1]; } }
                    u32x4 w; w.x = cvt_pk_bf16(v0[0], v0[1]); w.y = cvt_pk_bf16(v0[2], v0[3]); w.z = cvt_pk_bf16(v1[0], v1[1]); w.w = cvt_pk_bf16(v1[2], v1[3]);
                    *(u32x4*)(rowp + bj * HALF) = w; } }
        zero_acc(acc);
    }
};
struct EpiAct {
    static constexpr bool PERM = true;
    bf16_t* O; int ldc;
    __device__ __forceinline__ void operator()(Acc& acc, const Unit& u, int wr, int wc, int fr, int fq) const {
        const int row0 = u.pm * BM + wr * 64 + fr, col0 = u.pn * HALF + wc * 32 + 8 * fq;
#pragma unroll
        for (int ai = 0; ai < 2; ++ai)
#pragma unroll
            for (int m = 0; m < 4; ++m) { bf16_t* rowp = O + (size_t)(row0 + ai * HALF + m * 16) * ldc + col0;
                float r[8];
#pragma unroll
                for (int n = 0; n < 2; ++n)
#pragma unroll
                    for (int j = 0; j < 4; j += 2) { const f32x2_t g = {acc[ai][0][m][n][j], acc[ai][0][m][n][j + 1]}, up = {acc[ai][1][m][n][j], acc[ai][1][m][n][j + 1]};
                        const f32x2_t o = (g * up) * sigmoid2(g); r[n * 4 + j] = o[0]; r[n * 4 + j + 1] = o[1]; }
                u32x4 w; w.x = cvt_pk_bf16(r[0], r[1]); w.y = cvt_pk_bf16(r[2], r[3]); w.z = cvt_pk_bf16(r[4], r[5]); w.w = cvt_pk_bf16(r[6], r[7]);
                *(u32x4*)rowp = w; }
        zero_acc(acc);
    }
};
struct EpiRes {
    static constexpr bool PERM = true;
    const float* xin; float* xout; const float* gm;
    __device__ __forceinline__ void operator()(Acc& acc, const Unit& u, int wr, int wc, int fr, int fq) const {
        const int row0 = u.pm * BM + wr * 64 + fr, col0 = u.pn * BM + wc * 32 + 8 * fq;
        const float* gb = gm + (size_t)((u.pm * BM) / SEQ) * (6 * D);
        f32x4 gv[2][2];
#pragma unroll
        for (int bj = 0; bj < 2; ++bj)
#pragma unroll
            for (int n = 0; n < 2; ++n) gv[bj][n] = *(const f32x4*)(gb + col0 + bj * HALF + n * 4);
#pragma unroll
        for (int ai = 0; ai < 2; ++ai) {
            f32x4 xi[4][2][2];
#pragma unroll
            for (int m = 0; m < 4; ++m) { const size_t off = (size_t)(row0 + ai * HALF + m * 16) * D + col0;
#pragma unroll
                for (int bj = 0; bj < 2; ++bj)
#pragma unroll
                    for (int n = 0; n < 2; ++n) xi[m][bj][n] = *(const f32x4*)(xin + off + bj * HALF + n * 4); }
#pragma unroll
            for (int m = 0; m < 4; ++m) { const size_t off = (size_t)(row0 + ai * HALF + m * 16) * D + col0;
#pragma unroll
                for (int bj = 0; bj < 2; ++bj)
#pragma unroll
                    for (int n = 0; n < 2; ++n) *(f32x4*)(xout + off + bj * HALF + n * 4) = xi[m][bj][n] + gv[bj][n] * acc[ai][bj][m][n]; }
        }
        zero_acc(acc);
    }
};
struct EpiMerge {
    static constexpr bool PERM = true;
    const bf16_t* z; bf16_t* O;
    __device__ __forceinline__ void operator()(Acc& acc, const Unit& u, int wr, int wc, int fr, int fq) const {
        const int br = u.pm / (MH / BM), pm = u.pm - br * (MH / BM), pn = u.pn - br * (D / BM);
        const int row0 = pm * BM + wr * 64 + fr, col0 = pn * BM + wc * 32 + 8 * fq;
        const bf16_t* zg = z + ZG_A + br * D + col0;
#pragma unroll
        for (int ai = 0; ai < 2; ++ai) {
            u32x4 g0[4][2], g1[4][2];
#pragma unroll
            for (int m = 0; m < 4; ++m) { const size_t row = (size_t)(row0 + ai * HALF + m * 16);
#pragma unroll
                for (int bj = 0; bj < 2; ++bj) { g0[m][bj] = *(const u32x4*)(zg + row * NZ + bj * HALF);
                    if (br < 2) g1[m][bj] = *(const u32x4*)(zg + row * NZ + D + bj * HALF); } }
#pragma unroll
            for (int m = 0; m < 4; ++m) { const size_t row = (size_t)(row0 + ai * HALF + m * 16);
#pragma unroll
                for (int bj = 0; bj < 2; ++bj) {
                    float s[8];
                    if (br < 2) {
#pragma unroll
                        for (int e = 0; e < 4; ++e) {
                            const float a0 = __uint_as_float(g0[m][bj][e] << 16), a1 = __uint_as_float(g0[m][bj][e] & 0xffff0000u);
                            const float b0 = __uint_as_float(g1[m][bj][e] << 16), b1 = __uint_as_float(g1[m][bj][e] & 0xffff0000u);
                            s[2 * e] = a0 * __builtin_amdgcn_rcpf(fmaxf(b0, 1e-30f)); s[2 * e + 1] = a1 * __builtin_amdgcn_rcpf(fmaxf(b1, 1e-30f)); }
#pragma unroll
                        for (int n = 0; n < 2; ++n)
#pragma unroll
                            for (int j = 0; j < 4; ++j) acc[ai][bj][m][n][j] *= s[n * 4 + j];
                    } else {
#pragma unroll
                        for (int e = 0; e < 4; ++e) { s[2 * e] = __uint_as_float(g0[m][bj][e] << 16); s[2 * e + 1] = __uint_as_float(g0[m][bj][e] & 0xffff0000u); }
                        const f32x4 v0 = acc[ai][bj][m][0], v1 = acc[ai][bj][m][1];
                        u32x4 w; w.x = cvt_pk_bf16(v0[0] * s[0], v0[1] * s[1]); w.y = cvt_pk_bf16(v0[2] * s[2], v0[3] * s[3]);
                        w.z = cvt_pk_bf16(v1[0] * s[4], v1[1] * s[5]); w.w = cvt_pk_bf16(v1[2] * s[6], v1[3] * s[7]);
                        *(u32x4*)(O + row * D + col0 + bj * HALF) = w;
                        acc[ai][bj][m][0] = (f32x4){0.f, 0.f, 0.f, 0.f}; acc[ai][bj][m][1] = (f32x4){0.f, 0.f, 0.f, 0.f};
                    } } }
        }
    }
};

template <class Epi, class Sched>
__device__ __forceinline__ void gemm_phase(LAS unsigned char* lds, const Gemm g, const Sched& S, const Epi& E) {
    int tid_ = threadIdx.x; asm volatile("" : "+v"(tid_));
    const int tid = tid_, wid = __builtin_amdgcn_readfirstlane(tid >> 6), lane = tid & 63, wr = wid >> 2, wc = wid & 3, fr = lane & 15, fq = lane >> 4;
    const int K = g.K, nt = K / BK;
    unsigned voffA[2], voffB[2];
#pragma unroll
    for (int i = 0; i < 2; ++i) { int R, C; stage_rc(tid * 16 + i * 8192, R, C); const int Rb = Epi::PERM ? ((R & ~31) + perm32(R & 31)) : R;
        voffA[i] = (unsigned)(R * g.lda + C) * 2u; voffB[i] = (unsigned)(Rb * g.ldb + C) * 2u; }
    const size_t kstep = (size_t)(BK * 2);
    const size_t hstepA = (size_t)HALF * g.lda * 2, hstepB = (size_t)HALF * g.ldb * 2;
    const size_t tstepA = 2 * hstepA, tstepB = 2 * hstepB;
    const unsigned ldsw = (unsigned)wid * 1024u;
    const int aoff = lds_byte(wr * 64 + fr, fq * 8), boff = lds_byte(wc * 32 + fr, fq * 8);
#define PG8_SA(b, h) (((b) * 2 + (h)) * HTB)
#define PG8_SB(b, h) ((4 + (b) * 2 + (h)) * HTB)
#define PG8_STAGE(bufoff, gbase, voff) do { _Pragma("unroll") for (int _i = 0; _i < 2; ++_i) \
        __builtin_amdgcn_global_load_lds((const unsigned*)((const char*)(gbase) + (voff)[_i]), (LAS unsigned*)(lds + (bufoff) + ldsw + _i * 8192), 16, 0, 0); } while (0)
#define PG8_LDA(dst, b, h) do { _Pragma("unroll") for (int m = 0; m < 4; ++m) _Pragma("unroll") for (int k = 0; k < 2; ++k) dst[m][k] = *(const LAS bf16x8*)(lds + PG8_SA(b, h) + aoff + m * 2048 + k * 1024); } while (0)
#define PG8_LDB(dst, b, h) do { _Pragma("unroll") for (int n = 0; n < 2; ++n) _Pragma("unroll") for (int k = 0; k < 2; ++k) dst[n][k] = *(const LAS bf16x8*)(lds + PG8_SB(b, h) + boff + n * 2048 + k * 1024); } while (0)
#define PG8_MMA(ai, bj, At, Bt) do { __builtin_amdgcn_s_setprio(1); _Pragma("unroll") for (int m = 0; m < 4; ++m) _Pragma("unroll") for (int n = 0; n < 2; ++n) _Pragma("unroll") for (int k = 0; k < 2; ++k) \
        acc[ai][bj][m][n] = __builtin_amdgcn_mfma_f32_16x16x32_bf16(Bt[n][k], At[m][k], acc[ai][bj][m][n], 0, 0, 0); __builtin_amdgcn_s_setprio(0); } while (0)
#define PG8_WAIT_V(n) asm volatile("s_waitcnt vmcnt(" #n ")" ::: "memory")
#define PG8_WAIT_L(n) asm volatile("s_waitcnt lgkmcnt(" #n ")" ::: "memory")
#define PG8_BAR __builtin_amdgcn_s_barrier()
#define PG8_SCHED __builtin_amdgcn_sched_barrier(0)
    Unit cur, nxt; int ui = 0;
    if (!S.next(0, cur)) return;
    Acc acc; zero_acc(acc);
    bf16x8 At[4][2], B0[2][2], B1[2][2];
    const char* cA = (const char*)g.A + (size_t)cur.pm * tstepA; const char* cB = (const char*)g.Bt + (size_t)cur.pn * tstepB;
    PG8_STAGE(PG8_SB(0, 0), cB, voffB); PG8_STAGE(PG8_SA(0, 0), cA, voffA); PG8_STAGE(PG8_SB(0, 1), cB + hstepB, voffB); PG8_STAGE(PG8_SA(0, 1), cA + hstepA, voffA);
    if (wr == 1) PG8_BAR;
    PG8_WAIT_V(4); PG8_BAR;
    PG8_STAGE(PG8_SB(1, 0), cB + kstep, voffB); PG8_STAGE(PG8_SA(1, 0), cA + kstep, voffA); PG8_STAGE(PG8_SB(1, 1), cB + hstepB + kstep, voffB);
    PG8_WAIT_V(6); PG8_BAR;
    for (;;) {
        const bool has_next = S.next(ui + 1, nxt);
        const char* nA = has_next ? (const char*)g.A + (size_t)nxt.pm * tstepA : cA; const char* nB = has_next ? (const char*)g.Bt + (size_t)nxt.pn * tstepB : cB;
        for (int t = 0; t < nt; t += 2) {
            const bool last = (t == nt - 2);
            const char* a1 = cA + (size_t)(t + 1) * kstep;
            const char* a2 = last ? nA : cA + (size_t)(t + 2) * kstep; const char* b2 = last ? nB : cB + (size_t)(t + 2) * kstep;
            const char* a3 = a2 + kstep; const char* b3 = b2 + kstep;
            PG8_LDB(B0, 0, 0); PG8_SCHED; PG8_LDA(At, 0, 0); PG8_STAGE(PG8_SA(1, 1), a1 + hstepA, voffA);
            PG8_WAIT_L(8); PG8_BAR; PG8_WAIT_L(0); PG8_MMA(0, 0, At, B0); PG8_BAR; PG8_SCHED;
            PG8_LDB(B1, 0, 1); PG8_STAGE(PG8_SB(0, 0), b2, voffB);
            PG8_BAR; PG8_WAIT_L(0); PG8_MMA(0, 1, At, B1); PG8_BAR;
            PG8_LDA(At, 0, 1); PG8_STAGE(PG8_SA(0, 0), a2, voffA);
            PG8_BAR; PG8_WAIT_L(0); PG8_MMA(1, 0, At, B0); PG8_BAR; PG8_SCHED;
            PG8_STAGE(PG8_SB(0, 1), b2 + hstepB, voffB);
            PG8_WAIT_V(6); PG8_BAR; PG8_MMA(1, 1, At, B1); PG8_BAR;
            PG8_LDB(B0, 1, 0); PG8_SCHED; PG8_LDA(At, 1, 0); PG8_STAGE(PG8_SA(0, 1), a2 + hstepA, voffA);
            PG8_WAIT_L(8); PG8_BAR; PG8_WAIT_L(0); PG8_MMA(0, 0, At, B0); PG8_BAR; PG8_SCHED;
            PG8_LDB(B1, 1, 1); PG8_STAGE(PG8_SB(1, 0), b3, voffB);
            PG8_BAR; PG8_WAIT_L(0); PG8_MMA(0, 1, At, B1); PG8_BAR;
            PG8_LDA(At, 1, 1); PG8_STAGE(PG8_SA(1, 0), a3, voffA);
            PG8_BAR; PG8_WAIT_L(0); PG8_MMA(1, 0, At, B0); PG8_BAR; PG8_SCHED;
            PG8_STAGE(PG8_SB(1, 1), b3 + hstepB, voffB);
            PG8_WAIT_V(6); PG8_BAR; PG8_MMA(1, 1, At, B1); PG8_BAR;
        }
        E(acc, cur, wr, wc, fr, fq);
        if (!has_next) break;
        cur = nxt; cA = nA; cB = nB; ++ui;
    }
    PG8_WAIT_V(0);
    if (wr == 0) PG8_BAR;
    PG8_BAR;
#undef PG8_SA
#undef PG8_SB
#undef PG8_STAGE
#undef PG8_LDA
#undef PG8_LDB
#undef PG8_MMA
#undef PG8_WAIT_V
#undef PG8_WAIT_L
#undef PG8_BAR
#undef PG8_SCHED
}
}

__device__ void phase_prologue(const Params& p, LAS unsigned char* lds) {
    int tid_ = threadIdx.x; asm volatile("" : "+v"(tid_)); const int tid = tid_;
    for (int i = blockIdx.x * 512 + tid; i < SEQ * 32; i += gridDim.x * 512) {
        const int pos = i >> 5, fi = i & 31;
        const float invf = exp2f(-(float)fi * (13.287712379549449f / 32.0f));
        const float ang = (float)pos * invf;
        double rev = (double)ang * 0.15915494309189535;
        rev -= rint(rev);
        const float rf = (float)rev;
        p.rope[i] = make_float2(__builtin_amdgcn_cosf(rf), __builtin_amdgcn_sinf(rf));
    }
    if (blockIdx.x == 0) {
        const int i = tid;
        float lg[DEPTH], mx = -1e30f;
#pragma unroll
        for (int l = 0; l < DEPTH; ++l) { lg[l] = p.lb_logits[l * 512 + i]; mx = fmaxf(mx, lg[l]); }
        float s = 0.f;
#pragma unroll
        for (int l = 0; l < DEPTH; ++l) { lg[l] = expf(lg[l] - mx); s += lg[l]; }
        const float inv = 1.0f / s; const float p0 = lg[0] * inv; float cum = 0.f;
#pragma unroll
        for (int l = 0; l < DEPTH; ++l) { cum += lg[l] * inv; p.lb[l * 512 + i] = fmaxf(cum - p0, 0.0f); }
    }
    LAS float* cact = (LAS float*)lds;
    LAS float* red = (LAS float*)(lds + 65536);
    for (int item = blockIdx.x; item < DEPTH * 48; item += gridDim.x) {
        const int l = item / 48, cb = item % 48;
        for (int i = tid; i < BATCH * D; i += 512) { const float c = p.c[i]; cact[i] = c * sigmoidf_(c); }
        __syncthreads();
        const int col = tid & 127, kq = tid >> 7;
        float acc[16];
#pragma unroll
        for (int b = 0; b < 16; ++b) acc[b] = 0.f;
        const float* wp = p.w_ada + ((size_t)l * D + kq * 256) * (6 * D) + cb * 128 + col;
        for (int k = 0; k < 256; k += 4) {
            const float w0 = wp[(size_t)k * (6 * D)], w1 = wp[(size_t)(k + 1) * (6 * D)], w2 = wp[(size_t)(k + 2) * (6 * D)], w3 = wp[(size_t)(k + 3) * (6 * D)];
#pragma unroll
            for (int b = 0; b < 16; ++b) { const f32x4 cv = *(const LAS f32x4*)(cact + b * D + kq * 256 + k); acc[b] += cv[0] * w0 + cv[1] * w1 + cv[2] * w2 + cv[3] * w3; }
        }
#pragma unroll
        for (int b = 0; b < 16; ++b) red[(kq * 16 + b) * 128 + col] = acc[b];
        __syncthreads();
        for (int e = tid; e < 16 * 128; e += 512) {
            const int b = e >> 7, cc = e & 127;
            const float s = red[(0 * 16 + b) * 128 + cc] + red[(1 * 16 + b) * 128 + cc] + red[(2 * 16 + b) * 128 + cc] + red[(3 * 16 + b) * 128 + cc];
            p.mod[((size_t)l * BATCH + b) * (6 * D) + cb * 128 + cc] = s + p.b_ada[l * 6 * D + cb * 128 + cc];
        }
        __syncthreads();
    }
}

struct ConvTile { const float* src; int ldsrc; bf16_t* dst; int K; int k0; int n0; int kind; const float* wa; };
__device__ __forceinline__ int conv_srccol(int kind, int n) {
    if (kind == 1) return n < 5632 ? n : n < 8704 ? n + 32 : -2;
    if (kind == 2) { const int pn = n >> 8, bj = (n >> 7) & 1, ii = n & 127; return bj * DFF + pn * 128 + ii; }
    return n;
}
__device__ __forceinline__ ConvTile conv_decode(const Params& p, int l, int t) {
    constexpr int T_IN = 16 * 144, T_P = 3 * 8 * 16, T_OUT = 16 * 16, T_FI = 16 * 88;
    int i = t; ConvTile c;
    if (i < T_IN) { c = ConvTile{p.w_in + (size_t)l * D * NIN, NIN, p.wt_in, D, (i & 15) * 64, (i >> 4) * 64, 1, p.w_alpha + (size_t)l * 2 * 16 * 256}; return c; }
    i -= T_IN;
    if (i < T_P) { const int br = i / 128, r = i % 128;
        c = ConvTile{(br == 0 ? p.w_pa : br == 1 ? p.w_pb : p.w_pc) + (size_t)l * 512 * D, D, p.wt_p + (size_t)br * D * 512, 512, (r & 7) * 64, (r >> 3) * 64, 0, nullptr}; return c; }
    i -= T_P;
    if (i < T_OUT) { c = ConvTile{p.w_out + (size_t)l * D * D, D, p.wt_out, D, (i & 15) * 64, (i >> 4) * 64, 0, nullptr}; return c; }
    i -= T_OUT;
    if (i < T_FI) { c = ConvTile{p.w_ffn_in + (size_t)l * D * 2 * DFF, 2 * DFF, p.wt_fi, D, (i & 15) * 64, (i >> 4) * 64, 2, nullptr}; return c; }
    i -= T_FI;
    c = ConvTile{p.w_ffn_out + (size_t)l * DFF * D, D, p.wt_fo, DFF, (i % 44) * 64, (i / 44) * 64, 0, nullptr}; return c;
}
__device__ __forceinline__ void conv_load(const ConvTile& c, int tid, float (&v)[8]) {
    const int cidx = tid & 63;
    if (c.kind == 1 && c.n0 >= 8704) {
        const int fc = c.n0 + cidx - 8704, dr = fc >> 8, ch = fc & 255;
        float wa[16];
#pragma unroll
        for (int r = 0; r < 16; ++r) wa[r] = c.wa[(dr * 16 + r) * 256 + ch];
#pragma unroll
        for (int i = 0; i < 8; ++i) { const int r_ = (tid >> 6) + 8 * i; const float* sp = c.src + (size_t)(c.k0 + r_) * c.ldsrc + 5632 + dr * 16;
            float a = 0.f;
#pragma unroll
            for (int q = 0; q < 4; ++q) { const f32x4 t = *(const f32x4*)(sp + q * 4); a += t[0] * wa[q * 4] + t[1] * wa[q * 4 + 1] + t[2] * wa[q * 4 + 2] + t[3] * wa[q * 4 + 3]; }
            v[i] = a; }
        return;
    }
    const int col4 = (tid & 15) * 4; const int sc4 = conv_srccol(c.kind, c.n0 + col4);
#pragma unroll
    for (int i = 0; i < 2; ++i) { const int r = (tid >> 4) + 32 * i; const f32x4 t = *(const f32x4*)(c.src + (size_t)(c.k0 + r) * c.ldsrc + sc4);
        v[i * 4] = t[0]; v[i * 4 + 1] = t[1]; v[i * 4 + 2] = t[2]; v[i * 4 + 3] = t[3]; }
}
__device__ __forceinline__ void conv_to_lds(const ConvTile& c, int tid, LAS float* tile, const float (&v)[8]) {
    if (c.kind == 1 && c.n0 >= 8704) {
#pragma unroll
        for (int i = 0; i < 8; ++i) tile[((tid >> 6) + 8 * i) * 65 + (tid & 63)] = v[i];
    } else {
#pragma unroll
        for (int i = 0; i < 2; ++i)
#pragma unroll
            for (int j = 0; j < 4; ++j) tile[((tid >> 4) + 32 * i) * 65 + (tid & 15) * 4 + j] = v[i * 4 + j];
    }
}
__device__ void phase_conv(const Params& p, LAS unsigned char* lds, int l) {
    LAS float* tile = (LAS float*)lds;
    constexpr int TOT = 16 * 144 + 3 * 8 * 16 + 16 * 16 + 16 * 88 + 44 * 16;
    int tid_ = threadIdx.x; asm volatile("" : "+v"(tid_)); const int tid = tid_;
    int t = blockIdx.x;
    if (t >= TOT) return;
    ConvTile cur = conv_decode(p, l, t);
    float v[8]; conv_load(cur, tid, v);
    for (;;) {
        const int tn = t + gridDim.x; const bool has_next = tn < TOT;
        conv_to_lds(cur, tid, tile, v);
        ConvTile nxt = cur;
        if (has_next) { nxt = conv_decode(p, l, tn); conv_load(nxt, tid, v); }
        __syncthreads();
        {
            const int n = tid >> 3, kk = (tid & 7) * 8;
            float w[8];
#pragma unroll
            for (int j = 0; j < 8; ++j) w[j] = tile[(kk + j) * 65 + n];
            *(u32x4*)(cur.dst + (size_t)(cur.n0 + n) * cur.K + cur.k0 + kk) = (u32x4){cvt_pk_bf16(w[0], w[1]), cvt_pk_bf16(w[2], w[3]), cvt_pk_bf16(w[4], w[5]), cvt_pk_bf16(w[6], w[7])};
        }
        __syncthreads();
        if (!has_next) break;
        cur = nxt; t = tn;
    }
}

__device__ void phase_norm(const float* xg  , const float* gain, const float* modg  , int shoff, int scoff, bf16_t* h, int nrows) {
    int tid_ = threadIdx.x; asm volatile("" : "+v"(tid_));
    const int lane = tid_ & 63, wid = tid_ >> 6;
    for (int rg = blockIdx.x; rg < nrows / 16; rg += gridDim.x) {
        f32x4 v[2][4]; float ss[2] = {0.f, 0.f};
#pragma unroll
        for (int t = 0; t < 2; ++t) { const float* xr = xg + (size_t)(rg * 16 + t * 8 + wid) * D;
#pragma unroll
            for (int i = 0; i < 4; ++i) v[t][i] = *(const f32x4*)(xr + lane * 4 + i * 256); }
#pragma unroll
        for (int t = 0; t < 2; ++t) {
#pragma unroll
            for (int i = 0; i < 4; ++i) ss[t] += v[t][i][0] * v[t][i][0] + v[t][i][1] * v[t][i][1] + v[t][i][2] * v[t][i][2] + v[t][i][3] * v[t][i][3];
#pragma unroll
            for (int m = 32; m >= 1; m >>= 1) ss[t] += __shfl_xor(ss[t], m); }
#pragma unroll
        for (int t = 0; t < 2; ++t) {
            const int row = rg * 16 + t * 8 + wid; const float* mb = modg + (size_t)(row / SEQ) * (6 * D);
            const float rstd = rsqrtf(ss[t] * (1.0f / D) + 1e-6f);
#pragma unroll
            for (int i = 0; i < 4; ++i) { const int c = lane * 4 + i * 256;
                const f32x4 g = *(const f32x4*)(gain + c), sc = *(const f32x4*)(mb + scoff + c), sh = *(const f32x4*)(mb + shoff + c);
                float r[4];
#pragma unroll
                for (int j = 0; j < 4; ++j) r[j] = v[t][i][j] * rstd * g[j] * (1.0f + sc[j]) + sh[j];
                *(u32x2*)(h + (size_t)row * D + c) = (u32x2){cvt_pk_bf16(r[0], r[1]), cvt_pk_bf16(r[2], r[3])}; }
        }
    }
}
__device__ void phase_final(const Params& p) {
    int tid_ = threadIdx.x; asm volatile("" : "+v"(tid_));
    const int lane = tid_ & 63, wid = tid_ >> 6;
    f32x4 g[4];
#pragma unroll
    for (int i = 0; i < 4; ++i) g[i] = *(const f32x4*)(p.norm_f_g + lane * 4 + i * 256);
    for (int rg = blockIdx.x; rg < BATCH * SEQ / 16; rg += gridDim.x) {
        f32x4 v[2][4]; float ss[2];
#pragma unroll
        for (int t = 0; t < 2; ++t) { const float* xr = p.out + (size_t)(rg * 16 + t * 8 + wid) * D;
#pragma unroll
            for (int i = 0; i < 4; ++i) v[t][i] = *(const f32x4*)(xr + lane * 4 + i * 256); }
#pragma unroll
        for (int t = 0; t < 2; ++t) { ss[t] = 0.f;
#pragma unroll
            for (int i = 0; i < 4; ++i) ss[t] += v[t][i][0] * v[t][i][0] + v[t][i][1] * v[t][i][1] + v[t][i][2] * v[t][i][2] + v[t][i][3] * v[t][i][3];
#pragma unroll
            for (int m = 32; m >= 1; m >>= 1) ss[t] += __shfl_xor(ss[t], m); }
#pragma unroll
        for (int t = 0; t < 2; ++t) { float* xr = p.out + (size_t)(rg * 16 + t * 8 + wid) * D;
            const float rstd = rsqrtf(ss[t] * (1.0f / D) + 1e-6f);
#pragma unroll
            for (int i = 0; i < 4; ++i) *(f32x4*)(xr + lane * 4 + i * 256) = v[t][i] * rstd * g[i]; }
    }
}

template <int DK, int DV, int MIX>
__device__ void scan_item(const Params& p, LAS unsigned char* lds, int layer, int bl, int head, int dir, int vhalf) {
    constexpr int TG = 512 / DK, TPG = 64 / TG;
    constexpr int TGV = 512 / DV, TPGV = 64 / TGV;
    constexpr int SQ = DK * 2 + 16, S64 = 144;
    constexpr int OFF_QT = 0, OFF_KT = OFF_QT + 64 * SQ, OFF_QS = OFF_KT + 64 * SQ, OFF_KL = OFF_QS + 64 * SQ, OFF_VT = OFF_KL + DK * S64,
                  OFF_P = OFF_VT + DV * S64, OFF_ST = OFF_P + 64 * S64, OFF_TOT = OFF_ST + DV * SQ, OFF_EL = OFF_TOT + TG * DK * 4,
                  OFF_RQ = OFF_EL + DK * 4, OFF_RK = OFF_RQ + 64 * DK * 2, OFF_RV = OFF_RK + 64 * DK * 2, OFF_RL = OFF_RV + 64 * DV * 2, OFF_END = OFF_RL + (MIX == 2 ? 64 * 128 : 0);
    static_assert(OFF_END <= LDS_MAIN, "lds");
    static_assert(OFF_RQ % 1024 == 0 || true, "");
    constexpr int NV = DV / 32;
    int tid_ = threadIdx.x; asm volatile("" : "+v"(tid_));
    const int tid = tid_, lane = tid & 63, wid = __builtin_amdgcn_readfirstlane(tid >> 6), fr = lane & 15, fq = lane >> 4;
    const int d = tid % DK, g = tid / DK, vv = tid % DV, gv = tid / DV;
    const bf16_t* zb = p.z + (size_t)(bl * SEQ) * NZ;
    int cbq, cbk, cbv;
    if (MIX == 0) { cbq = ZA_Q + head * 128; cbk = (dir ? ZA_FB : ZA_FF) + head * 128; cbv = ZA_I + head * 128 + vhalf * 64; }
    else if (MIX == 1) { cbq = ZB_Q + head * 64; cbk = ZB_K + head * 64; cbv = ZB_V + head * 128; }
    else { cbq = ZC_Q + head * 64; cbk = ZC_K + head * 64; cbv = ZC_V + head * 128; }
    float lbv = 0.f, oml = 1.f, gam = 1.f, bal = 0.f;
    if (MIX == 0) { lbv = p.lb[layer * 512 + head * 128 + d]; oml = 1.0f - lbv; }
    if (MIX == 1) { const int hh = dir ? 3 - head : head; gam = 1.0f - exp2f(-5.0f - (float)hh); }
    if (MIX == 2) bal = p.b_alpha[((size_t)layer * 2 + dir) * 256 + head * 64 + d];
    const int cbl = ZC_LG + dir * 256 + head * 64;
    float2 rin[TPG];
    if (MIX == 1) {
#pragma unroll
        for (int tt = 0; tt < TPG; ++tt) { const int ip = g * TPG + tt; rin[tt] = p.rope[(dir ? 63 - ip : ip) * 32 + (d & 31)]; }
    }
    f32x4 S[4];
#pragma unroll
    for (int q = 0; q < 4; ++q) S[q] = (f32x4){0.f, 0.f, 0.f, 0.f};
    for (int i = tid * 16; i < DV * SQ; i += 512 * 16) *(LAS u32x4*)(lds + OFF_ST + i) = (u32x4){0u, 0u, 0u, 0u};
    const int ti = wid & 3;
    const int tj0 = (wid >> 2) * 2;
    const int tv0 = (wid >> 2) * NV;

    auto stage_rows = [&](int cn, int ldsoff, int colbase, int rbshift  ) {
        const int n = dir ? 31 - cn : cn;
        const bf16_t* zc = zb + (size_t)(n * 64) * NZ + colbase;
        const int rpw = 1024 >> rbshift, nwl = 64 / rpw, l16 = (1 << rbshift) >> 4;
        for (int wl = wid; wl < nwl; wl += 8) {
            const int row = wl * rpw + lane / l16, c16 = lane % l16; const int tk = dir ? 63 - row : row;
            __builtin_amdgcn_global_load_lds((const unsigned*)(zc + (size_t)tk * NZ + c16 * 8), (LAS unsigned*)(lds + ldsoff + wl * 1024), 16, 0, 0);
        }
    };
    constexpr int RBQ = (DK == 128) ? 8 : 7, RBV = (DV == 128) ? 8 : 7;
    stage_rows(0, OFF_RQ, cbq, RBQ); stage_rows(0, OFF_RK, cbk, RBQ); stage_rows(0, OFF_RV, cbv, RBV);
    if (MIX == 2) stage_rows(0, OFF_RL, cbl, 7);
    asm volatile("s_waitcnt vmcnt(0)" ::: "memory");
    __syncthreads();

    for (int cn = 0; cn < 32; ++cn) {
        const int n = dir ? 31 - cn : cn;
        float qv[TPG], kv[TPG], pl[TPG], sl[TPG];
        {
            float f[TPG];
            float2 rcs[TPG];
            if (MIX == 1) {
                const float2 cb = p.rope[(n * 64) * 32 + (d & 31)];
#pragma unroll
                for (int tt = 0; tt < TPG; ++tt) rcs[tt] = make_float2(cb.x * rin[tt].x - cb.y * rin[tt].y, cb.y * rin[tt].x + cb.x * rin[tt].y);
            }
#pragma unroll
            for (int tt = 0; tt < TPG; ++tt) {
                const int ip = g * TPG + tt;
                if (MIX == 0) {
                    qv[tt] = bf2f(*(const LAS bf16_t*)(lds + OFF_RQ + ip * (DK * 2) + d * 2));
                    const float sg = bf2f(*(const LAS bf16_t*)(lds + OFF_RK + ip * (DK * 2) + d * 2));
                    f[tt] = fmaxf(lbv + oml * sg, 1e-30f); kv[tt] = oml * (1.0f - sg);
                } else if (MIX == 1) {
                    const int dl = d & 31;
                    const float q1 = bf2f(*(const LAS bf16_t*)(lds + OFF_RQ + ip * (DK * 2) + dl * 2)), q2 = bf2f(*(const LAS bf16_t*)(lds + OFF_RQ + ip * (DK * 2) + dl * 2 + 64));
                    const float k1 = bf2f(*(const LAS bf16_t*)(lds + OFF_RK + ip * (DK * 2) + dl * 2)), k2 = bf2f(*(const LAS bf16_t*)(lds + OFF_RK + ip * (DK * 2) + dl * 2 + 64));
                    const float2 cs = rcs[tt];
                    if (d < 32) { qv[tt] = q1 * cs.x - q2 * cs.y; kv[tt] = (k1 * cs.x - k2 * cs.y) * 0.125f; }
                    else        { qv[tt] = q1 * cs.y + q2 * cs.x; kv[tt] = (k1 * cs.y + k2 * cs.x) * 0.125f; }
                    f[tt] = gam;
                } else {
                    qv[tt] = bf2f(*(const LAS bf16_t*)(lds + OFF_RQ + ip * (DK * 2) + d * 2)) * 0.125f; kv[tt] = bf2f(*(const LAS bf16_t*)(lds + OFF_RK + ip * (DK * 2) + d * 2));
                    const float logit = bal + bf2f(*(const LAS bf16_t*)(lds + OFF_RL + ip * 128 + d * 2));
                    const float lg = (fminf(logit, 0.f) - __logf(1.0f + __expf(-fabsf(logit)))) * (1.0f / 16.0f);
                    f[tt] = __expf(lg);
                }
            }
            pl[0] = f[0];
#pragma unroll
            for (int tt = 1; tt < TPG; ++tt) pl[tt] = pl[tt - 1] * f[tt];
            sl[TPG - 1] = 1.0f;
#pragma unroll
            for (int tt = TPG - 2; tt >= 0; --tt) sl[tt] = sl[tt + 1] * f[tt + 1];
        }
        ((LAS float*)(lds + OFF_TOT))[g * DK + d] = pl[TPG - 1];
        __syncthreads();
        if (cn + 1 < 32) { stage_rows(cn + 1, OFF_RQ, cbq, RBQ); stage_rows(cn + 1, OFF_RK, cbk, RBQ); if (MIX == 2) stage_rows(cn + 1, OFF_RL, cbl, 7); }
        {
            unsigned vp[TPGV / 2];
#pragma unroll
            for (int tt = 0; tt < TPGV; tt += 2) { const int ip = gv * TPGV + tt;
                vp[tt >> 1] = (unsigned)*(const LAS bf16_t*)(lds + OFF_RV + ip * (DV * 2) + vv * 2) | ((unsigned)*(const LAS bf16_t*)(lds + OFF_RV + (ip + 1) * (DV * 2) + vv * 2) << 16); }
            float H1 = 1.f, H2 = 1.f, R = 1.f, Fh = 1.f, Gl = 1.f, Gh = 1.f;
#pragma unroll
            for (int gg = 0; gg < TG; ++gg) { const float t = ((LAS float*)(lds + OFF_TOT))[gg * DK + d];
                if (gg < TG / 2) { H1 *= t; if (gg >= g) R *= t; if (gg > g) Gl *= t; }
                else { H2 *= t; if (gg < g) Fh *= t; if (gg > g) Gh *= t; } }
            const float Fg = (g < TG / 2) ? __builtin_amdgcn_rcpf(fmaxf(R, 1e-30f)) : Fh;
            const float Gg = (g < TG / 2) ? Gl : Gh * __builtin_amdgcn_rcpf(fmaxf(H2, 1e-30f));
            if (g == 0) ((LAS float*)(lds + OFF_EL))[d] = H1 * H2;
            unsigned klp[TPG / 2];
#pragma unroll
            for (int tt = 0; tt < TPG; tt += 2) {
                const int ip = g * TPG + tt;
                const float qa = qv[tt] * (pl[tt] * Fg), qb = qv[tt + 1] * (pl[tt + 1] * Fg);
                const float ka = kv[tt] * (sl[tt] * Gg), kb = kv[tt + 1] * (sl[tt + 1] * Gg);
                const unsigned wq = cvt_pk_bf16(qa, qb), wk = cvt_pk_bf16(ka, kb), ws = cvt_pk_bf16(qa * H1, qb * H1);
                *(LAS bf16_t*)(lds + OFF_QT + ip * SQ + d * 2) = (bf16_t)wq; *(LAS bf16_t*)(lds + OFF_QT + (ip + 1) * SQ + d * 2) = (bf16_t)(wq >> 16);
                *(LAS bf16_t*)(lds + OFF_KT + ip * SQ + d * 2) = (bf16_t)wk; *(LAS bf16_t*)(lds + OFF_KT + (ip + 1) * SQ + d * 2) = (bf16_t)(wk >> 16);
                *(LAS bf16_t*)(lds + OFF_QS + ip * SQ + d * 2) = (bf16_t)ws; *(LAS bf16_t*)(lds + OFF_QS + (ip + 1) * SQ + d * 2) = (bf16_t)(ws >> 16);
                klp[tt >> 1] = cvt_pk_bf16(ka * H2, kb * H2);
            }
#pragma unroll
            for (int q = 0; q < TPG / 8; ++q) *(LAS u32x4*)(lds + OFF_KL + d * S64 + (g * TPG + q * 8) * 2) = (u32x4){klp[q * 4], klp[q * 4 + 1], klp[q * 4 + 2], klp[q * 4 + 3]};
#pragma unroll
            for (int q = 0; q < TPGV / 8; ++q) *(LAS u32x4*)(lds + OFF_VT + vv * S64 + (gv * TPGV + q * 8) * 2) = (u32x4){vp[q * 4], vp[q * 4 + 1], vp[q * 4 + 2], vp[q * 4 + 3]};
        }
        __syncthreads();
        if (cn + 1 < 32) stage_rows(cn + 1, OFF_RV, cbv, RBV);
        f32x4 oa[NV];
        {
            f32x4 sc[2] = {(f32x4){0.f, 0.f, 0.f, 0.f}, (f32x4){0.f, 0.f, 0.f, 0.f}};
#pragma unroll
            for (int q = 0; q < NV; ++q) oa[q] = (f32x4){0.f, 0.f, 0.f, 0.f};
#pragma unroll
            for (int ks = 0; ks < DK / 32; ++ks) {
                const bf16x8 bq = *(const LAS bf16x8*)(lds + OFF_QT + (ti * 16 + fr) * SQ + ks * 64 + fq * 16);
#pragma unroll
                for (int jj = 0; jj < 2; ++jj) { const bf16x8 ak = *(const LAS bf16x8*)(lds + OFF_KT + ((tj0 + jj) * 16 + fr) * SQ + ks * 64 + fq * 16);
                    sc[jj] = __builtin_amdgcn_mfma_f32_16x16x32_bf16(ak, bq, sc[jj], 0, 0, 0); }
                const bf16x8 bs = *(const LAS bf16x8*)(lds + OFF_QS + (ti * 16 + fr) * SQ + ks * 64 + fq * 16);
#pragma unroll
                for (int q = 0; q < NV; ++q) { const bf16x8 as = *(const LAS bf16x8*)(lds + OFF_ST + ((tv0 + q) * 16 + fr) * SQ + ks * 64 + fq * 16);
                    oa[q] = __builtin_amdgcn_mfma_f32_16x16x32_bf16(as, bs, oa[q], 0, 0, 0); }
            }
            const int ipc = ti * 16 + fr;
#pragma unroll
            for (int jj = 0; jj < 2; ++jj) { const int jp0 = (tj0 + jj) * 16 + fq * 4; float m[4];
#pragma unroll
                for (int r = 0; r < 4; ++r) { const int jp = jp0 + r; const bool keep = dir ? (jp < ipc) : (jp <= ipc); m[r] = keep ? sc[jj][r] : 0.f; }
                *(LAS u32x2*)(lds + OFF_P + ipc * S64 + jp0 * 2) = (u32x2){cvt_pk_bf16(m[0], m[1]), cvt_pk_bf16(m[2], m[3])}; }
        }
        asm volatile("s_waitcnt vmcnt(0)" ::: "memory");
        __syncthreads();
        {
#pragma unroll
            for (int ks = 0; ks < 2; ++ks) {
                const bf16x8 bp = *(const LAS bf16x8*)(lds + OFF_P + (ti * 16 + fr) * S64 + ks * 64 + fq * 16);
#pragma unroll
                for (int q = 0; q < NV; ++q) { const bf16x8 av = *(const LAS bf16x8*)(lds + OFF_VT + ((tv0 + q) * 16 + fr) * S64 + ks * 64 + fq * 16);
                    oa[q] = __builtin_amdgcn_mfma_f32_16x16x32_bf16(av, bp, oa[q], 0, 0, 0); }
            }
            const int ip = ti * 16 + fr; const int tk = dir ? 63 - ip : ip;
            bf16_t* op = p.o + ((size_t)(dir * 3 + MIX) * MH + bl * SEQ + n * 64 + tk) * 512 + head * 128 + vhalf * 64;
#pragma unroll
            for (int q = 0; q < NV; ++q) *(u32x2*)(op + (tv0 + q) * 16 + fq * 4) = (u32x2){cvt_pk_bf16(oa[q][0], oa[q][1]), cvt_pk_bf16(oa[q][2], oa[q][3])};
        }
#pragma unroll
        for (int q = 0; q < 4; ++q) {
            const int tix = wid * 4 + q, td = tix / (DV / 16), tv = tix % (DV / 16);
            const f32x4 el = *(const LAS f32x4*)(lds + OFF_EL + (td * 16 + fq * 4) * 4);
            S[q] *= el;
#pragma unroll
            for (int ks = 0; ks < 2; ++ks) {
                const bf16x8 ak = *(const LAS bf16x8*)(lds + OFF_KL + (td * 16 + fr) * S64 + ks * 64 + fq * 16);
                const bf16x8 bv = *(const LAS bf16x8*)(lds + OFF_VT + (tv * 16 + fr) * S64 + ks * 64 + fq * 16);
                S[q] = __builtin_amdgcn_mfma_f32_16x16x32_bf16(ak, bv, S[q], 0, 0, 0);
            }
            *(LAS u32x2*)(lds + OFF_ST + (tv * 16 + fr) * SQ + (td * 16 + fq * 4) * 2) = (u32x2){cvt_pk_bf16(S[q][0], S[q][1]), cvt_pk_bf16(S[q][2], S[q][3])};
        }
    }
    asm volatile("s_waitcnt vmcnt(0)" ::: "memory");
    __syncthreads();
}
__device__ void phase_scan(const Params& p, LAS unsigned char* lds, int layer) {
    for (int item = blockIdx.x; item < 256; item += gridDim.x) {
        if (item < 128) { const int vhalf = item & 1, dir = (item >> 1) & 1, head = (item >> 2) & 3, bl = item >> 4; scan_item<128, 64, 0>(p, lds, layer, bl, head, dir, vhalf); }
        else if (item < 192) { const int i = item - 128, dir = i & 1, head = (i >> 1) & 3, bl = i >> 3; scan_item<64, 128, 1>(p, lds, layer, bl, head, dir, 0); }
        else { const int i = item - 192, dir = i & 1, head = (i >> 1) & 3, bl = i >> 3; scan_item<64, 128, 2>(p, lds, layer, bl, head, dir, 0); }
    }
}

__device__ void phase_ypass(const Params& p, int layer) {
    int tid_ = threadIdx.x; asm volatile("" : "+v"(tid_));
    const int lane = tid_ & 63, wid = tid_ >> 6;
    const int ch = (lane >> 4) * 128 + (lane & 15) * 8;
    f32x4 gn[3][2];
#pragma unroll
    for (int br = 0; br < 3; ++br) { const float* g = (br == 0 ? p.norm_a_g : br == 1 ? p.norm_b_g : p.norm_c_g) + layer * 512 + ch; gn[br][0] = *(const f32x4*)g; gn[br][1] = *(const f32x4*)(g + 4); }
    for (int rg = blockIdx.x; rg < MH / 16; rg += gridDim.x) {
        u32x4 a[2][3], b[2][3], gz[2][3];
#pragma unroll
        for (int t = 0; t < 2; ++t) { const int tok = rg * 16 + t * 8 + wid; const bf16_t* zr = p.z + (size_t)tok * NZ;
#pragma unroll
            for (int br = 0; br < 3; ++br) {
                a[t][br] = *(const u32x4*)(p.o + ((size_t)br * MH + tok) * 512 + ch);
                b[t][br] = *(const u32x4*)(p.o + ((size_t)(3 + br) * MH + tok) * 512 + ch);
                gz[t][br] = *(const u32x4*)(zr + (br == 0 ? ZA_G : br == 1 ? ZB_G : ZC_G) + ch); } }
#pragma unroll
        for (int t = 0; t < 2; ++t) { const int tok = rg * 16 + t * 8 + wid;
#pragma unroll
            for (int br = 0; br < 3; ++br) {
                float s[8], gt[8];
#pragma unroll
                for (int e = 0; e < 4; ++e) {
                    s[2 * e] = __uint_as_float(a[t][br][e] << 16) + __uint_as_float(b[t][br][e] << 16);
                    s[2 * e + 1] = __uint_as_float(a[t][br][e] & 0xffff0000u) + __uint_as_float(b[t][br][e] & 0xffff0000u);
                    gt[2 * e] = __uint_as_float(gz[t][br][e] << 16); gt[2 * e + 1] = __uint_as_float(gz[t][br][e] & 0xffff0000u); }
                float mu = 0.f;
                if (br == 1) {
#pragma unroll
                    for (int j = 0; j < 8; ++j) mu += s[j];
#pragma unroll
                    for (int m = 8; m >= 1; m >>= 1) mu += __shfl_xor(mu, m);
                    mu *= (1.0f / 128.0f);
                }
                float ss = 0.f;
#pragma unroll
                for (int j = 0; j < 8; ++j) { s[j] -= mu; ss += s[j] * s[j]; }
#pragma unroll
                for (int m = 8; m >= 1; m >>= 1) ss += __shfl_xor(ss, m);
                const float rstd = rsqrtf(ss * (1.0f / 128.0f) + 1e-6f);
                float r[8];
#pragma unroll
                for (int j = 0; j < 8; ++j) { const float gn_ = gn[br][j >> 2][j & 3]; const float sg = sigmoidf_(gt[j]);
                    const float act = br == 0 ? sg : gt[j] * sg; r[j] = s[j] * rstd * gn_ * act; }
                *(u32x4*)(p.o + ((size_t)br * MH + tok) * 512 + ch) = (u32x4){cvt_pk_bf16(r[0], r[1]), cvt_pk_bf16(r[2], r[3]), cvt_pk_bf16(r[4], r[5]), cvt_pk_bf16(r[6], r[7])};
            } }
    }
}

#define XB_TMO      128
#define XB_XCNT(j)  (256  + 64 * (j))
#define XB_XSUB(j)  (1280 + 64 * (j))
#define XB_XGEN(j)  (2304 + 64 * (j))
#define XB_TOP      3328
#define XB_TOPGEN   3392
#define XCD_BAR_WORDS 3456
#define XB_SPIN_CAP (1u << 22)
__device__ __forceinline__ unsigned xb_ld(unsigned* p)              { return __hip_atomic_load(p, __ATOMIC_RELAXED, __HIP_MEMORY_SCOPE_AGENT); }
__device__ __forceinline__ unsigned xb_add(unsigned* p, unsigned v) { return __hip_atomic_fetch_add(p, v, __ATOMIC_RELAXED, __HIP_MEMORY_SCOPE_AGENT); }
__device__ __forceinline__ unsigned xb_xcc_id() { return (unsigned)__builtin_amdgcn_s_getreg((3 << 11) | 20) & 0xFu; }
#define XB_SPIN(cond, bar) do { unsigned _sp = 0; while (cond) { __builtin_amdgcn_s_sleep(1); \
    if ((++_sp & 255u) == 0u) { if (xb_ld(&(bar)[XB_TMO])) break; if (_sp > XB_SPIN_CAP) { atomicAdd(&(bar)[XB_TMO], 1u); break; } } } } while (0)
struct XcdBarrier { unsigned* bar; unsigned x; volatile LAS unsigned* st; };
__device__ __forceinline__ XcdBarrier xcd_barrier_post(unsigned* bar, volatile LAS unsigned* st) {
    XcdBarrier b; b.bar = bar; b.x = xb_xcc_id(); b.st = st;
    if (threadIdx.x == 0) (void)xb_add(&bar[XB_XCNT(b.x)], 1u);
    return b;
}
__device__ __forceinline__ void xcd_barrier_complete(unsigned* bar, unsigned x, unsigned& nloc, unsigned& nx) {
    const unsigned G = gridDim.x * gridDim.y * gridDim.z;
    unsigned sum, cnt, mine, sp = 0u;
    for (;;) {
        sum = 0u; cnt = 0u; mine = 0u;
#pragma unroll
        for (unsigned j = 0; j < 16; ++j) { const unsigned c = xb_ld(&bar[XB_XCNT(j)]); sum += c; cnt += (c > 0u) ? 1u : 0u; mine = (j == x) ? c : mine; }
        if (sum == G) break;
        __builtin_amdgcn_s_sleep(1);
        if ((++sp & 255u) == 0u) { if (xb_ld(&bar[XB_TMO])) break; if (sp > XB_SPIN_CAP) { atomicAdd(&bar[XB_TMO], 1u); break; } }
    }
    nloc = mine > 0u ? mine : 1u; nx = cnt > 0u ? cnt : 1u;
}
__device__ __forceinline__ void xcd_barrier(const XcdBarrier& b) {
    asm volatile("s_waitcnt vmcnt(0)" ::: "memory");
    __syncthreads();
    if (threadIdx.x == 0) {
        unsigned* bar = b.bar;
        __builtin_amdgcn_s_waitcnt(0);
        unsigned nloc = b.st[0], nx = b.st[1];
        if (nloc == 0u) { xcd_barrier_complete(bar, b.x, nloc, nx); b.st[0] = nloc; b.st[1] = nx; }
        const unsigned old = xb_add(&bar[XB_XSUB(b.x)], 1u);
        const unsigned gen = old / nloc;
        if (old + 1u == (gen + 1u) * nloc) {
            __builtin_amdgcn_fence(__ATOMIC_RELEASE, "agent");
            asm volatile("s_waitcnt vmcnt(0)" ::: "memory");
            const unsigned og = xb_add(&bar[XB_TOP], 1u);
            const unsigned tg = og / nx;
            if (og + 1u == (tg + 1u) * nx) xb_add(&bar[XB_TOPGEN], 1u);
            else XB_SPIN(xb_ld(&bar[XB_TOPGEN]) == tg, bar);
            __builtin_amdgcn_fence(__ATOMIC_ACQUIRE, "agent");
            xb_add(&bar[XB_XGEN(b.x)], 1u);
            asm volatile("s_waitcnt vmcnt(0)" ::: "memory");
        } else {
            XB_SPIN(xb_ld(&bar[XB_XGEN(b.x)]) == gen, bar);
            __builtin_amdgcn_fence(__ATOMIC_ACQUIRE, "agent");
            asm volatile("s_waitcnt vmcnt(0)" ::: "memory");
        }
    }
    __syncthreads();
}

constexpr int N_PHASES = 1 + DEPTH * (1 + 1 + NGRP * 4 + 3) + 1;

__global__ void __launch_bounds__(512, 2) mega(Params p, int ph0, int ph1) {
    extern __shared__ __attribute__((aligned(16))) unsigned char shm[];
    LAS unsigned char* lds = (LAS unsigned char*)shm;
    cg::grid_group grid = cg::this_grid();
    volatile LAS unsigned* xst = (volatile LAS unsigned*)(lds + LDS_MAIN);
    if (threadIdx.x == 0) { xst[0] = 0u; xst[1] = 0u; }
    __syncthreads();
    const XcdBarrier xb = xcd_barrier_post(p.bar, xst);
    int pc = 0;
#define PHASE_BEGIN if (pc >= ph0 && pc < ph1) {
#define PHASE_END   if (pc + 1 < ph1) { if (ph1 < 0) grid.sync(); else xcd_barrier(xb); } } ++pc;
    PHASE_BEGIN
        phase_prologue(p, lds);
        phase_conv(p, lds, 0);
    PHASE_END
    for (int l = 0; l < DEPTH; ++l) {
        const float* modL = p.mod + (size_t)l * BATCH * (6 * D);
        const float* xinL = (l == 0 ? p.x : p.out);
        PHASE_BEGIN
            if (l > 0) phase_conv(p, lds, l);
            phase_norm(xinL, p.norm1_g + l * D, modL, 0, D, p.h, 2 * MH);
        PHASE_END
        for (int grp = 0; grp < NGRP; ++grp) {
            const float* modg = modL + (size_t)grp * GB * (6 * D);
            float* xg = p.out + (size_t)grp * MH * D;
            const float* xin0 = xinL + (size_t)grp * MH * D;
            bf16_t* hg = p.h + (size_t)grp * MH * D;
            if (grp == 0) {
            PHASE_BEGIN
                pg8::Gemm g{hg, p.wt_in, D, D, D}; pg8::ProjOrder S; S.base.init(MH, NZ, gridDim.x, blockIdx.x);
                pg8::EpiZ E{p.z, NZ}; pg8::gemm_phase(lds, g, S, E);
            PHASE_END
            }
            PHASE_BEGIN
                phase_scan(p, lds, l);
            PHASE_END
            PHASE_BEGIN
                phase_ypass(p, l);
            PHASE_END
            PHASE_BEGIN
                pg8::Gemm g{p.o, p.wt_p, 512, 512, 512}; pg8::MergeOrder S; S.base.init(MH, D, gridDim.x, blockIdx.x);
                pg8::EpiMerge E{p.z, hg}; pg8::gemm_phase(lds, g, S, E);
            PHASE_END
            PHASE_BEGIN
                { pg8::Gemm g{hg, p.wt_out, D, D, D}; pg8::StaticOrder S; S.init(MH, D, gridDim.x, blockIdx.x);
                  pg8::EpiRes E{xin0, xg, modg + 2 * D}; pg8::gemm_phase(lds, g, S, E); }
                if (grp == 0) {
                    pg8::Gemm g{p.h + (size_t)MH * D, p.wt_in, D, D, D}; pg8::ProjOrder S; S.base.init(MH, NZ, gridDim.x, blockIdx.x);
                    pg8::EpiZ E{p.z, NZ}; pg8::gemm_phase(lds, g, S, E);
                }
            PHASE_END
        }
        {
            const float* modl = p.mod + (size_t)l * BATCH * (6 * D);
            PHASE_BEGIN
                phase_norm(p.out, p.norm2_g + l * D, modl, 3 * D, 4 * D, p.h2, 2 * MH);
            PHASE_END
            PHASE_BEGIN
                pg8::Gemm g{p.h2, p.wt_fi, D, D, D}; pg8::StaticOrder S; S.init(2 * MH, 2 * DFF, gridDim.x, blockIdx.x);
                pg8::EpiAct E{p.z, DFF}; pg8::gemm_phase(lds, g, S, E);
            PHASE_END
            PHASE_BEGIN
                pg8::Gemm g{p.z, p.wt_fo, DFF, DFF, DFF}; pg8::StaticOrder S; S.init(2 * MH, D, gridDim.x, blockIdx.x);
                pg8::EpiRes E{p.out, p.out, modl + 5 * D}; pg8::gemm_phase(lds, g, S, E);
            PHASE_END
        }
    }
    PHASE_BEGIN
        phase_final(p);
    PHASE_END
}

extern "C" void kernel_launch(void* const* d_in, const int* in_sizes, int n_in, void* d_out, int out_size, void* d_ws, size_t ws_size, hipStream_t stream) {
    Params p{};
    const float** f = (const float**)&p;
    for (int i = 0; i < 20; ++i) f[i] = (const float*)d_in[i];
    p.out = (float*)d_out;
    char* w = (char*)d_ws; size_t off = 0;
    auto take = [&](size_t bytes) { char* r = w + off; off += (bytes + 255) & ~(size_t)255; return r; };
    p.wt_in = (bf16_t*)take((size_t)NZ * D * 2);
    p.wt_p = (bf16_t*)take((size_t)3 * D * 512 * 2);
    p.wt_out = (bf16_t*)take((size_t)D * D * 2);
    p.wt_fi = (bf16_t*)take((size_t)2 * DFF * D * 2);
    p.wt_fo = (bf16_t*)take((size_t)D * DFF * 2);
    p.mod = (float*)take((size_t)DEPTH * BATCH * 6 * D * 4);
    p.lb = (float*)take((size_t)DEPTH * 512 * 4);
    p.rope = (float2*)take((size_t)SEQ * 32 * 8);
    p.h = (bf16_t*)take((size_t)2 * MH * D * 2);
    p.h2 = p.h;
    p.z = (bf16_t*)take((size_t)MH * NZ * 2);
    p.o = (bf16_t*)take((size_t)2 * 3 * MH * 512 * 2);
    p.bar = (unsigned*)take((size_t)XCD_BAR_WORDS * 4);
    if (off > ws_size) { fprintf(stderr, "workspace too small: need %zu have %zu\n", off, ws_size); return; }
    static int grid_blocks = 0;
    if (!grid_blocks) {
        (void)hipFuncSetAttribute((const void*)mega, hipFuncAttributeMaxDynamicSharedMemorySize, LDS_BYTES);
        int dev = 0, cus = 0, per_cu = 0;
        (void)hipGetDevice(&dev);
        (void)hipDeviceGetAttribute(&cus, hipDeviceAttributeMultiprocessorCount, dev);
        (void)hipOccupancyMaxActiveBlocksPerMultiprocessor(&per_cu, mega, 512, LDS_BYTES);
        if (per_cu < 1) per_cu = 1;
        grid_blocks = cus * 1;
    }
    (void)hipMemsetAsync(p.bar, 0, (size_t)XCD_BAR_WORDS * 4, stream);
#if MULTI_LAUNCH
    for (int ph = 0; ph < N_PHASES; ++ph)
        hipLaunchKernelGGL(mega, dim3(grid_blocks), dim3(512), LDS_BYTES, stream, p, ph, ph + 1);
#else
    int ph0 = 0, ph1 = N_PHASES;
    void* args[] = {&p, &ph0, &ph1};
    hipError_t e = hipLaunchCooperativeKernel((void*)mega, dim3(grid_blocks), dim3(512), args, LDS_BYTES, stream);
    if (e != hipSuccess) fprintf(stderr, "cooperative launch failed: %s (grid %d)\n", hipGetErrorString(e), grid_blocks);
#endif
}
```

```cpp
#include <hip/hip_runtime.h>
#include <hip/hip_cooperative_groups.h>
#include <cstdio>
namespace cg = cooperative_groups;

#ifndef MULTI_LAUNCH
#define MULTI_LAUNCH 0
#endif

#define LAS __attribute__((address_space(3)))
typedef unsigned short bf16_t;
typedef short bf16x8 __attribute__((ext_vector_type(8)));
typedef float f32x4 __attribute__((ext_vector_type(4)));
typedef unsigned u32x4 __attribute__((ext_vector_type(4)));
typedef unsigned u32x2 __attribute__((ext_vector_type(2)));

constexpr int D = 1024, BATCH = 16, SEQ = 2048, DEPTH = 4;
constexpr int GB = 8;
constexpr int NGRP = BATCH / GB;
constexpr int MH = GB * SEQ;
constexpr int NIN = 8736, NZ = 9216, DFF = 2816;
constexpr int LDS_MAIN = 155648;
constexpr int LDS_BYTES = LDS_MAIN + 16;
constexpr int ZA_Q = 0, ZA_FF = 512, ZA_FB = 1024, ZA_I = 1536, ZA_G = 2048;
constexpr int ZB_Q = 2560, ZB_K = 2816, ZB_V = 3072, ZB_G = 3584;
constexpr int ZC_Q = 4096, ZC_K = 4352, ZC_V = 4608, ZC_G = 5120, ZC_LG = 8704;
constexpr int ZG_A = 5632;

struct Params {
    const float *x, *c, *norm1_g, *w_ada, *b_ada, *w_in, *lb_logits, *norm_a_g, *norm_b_g, *norm_c_g, *w_alpha, *b_alpha,
                *w_pa, *w_pb, *w_pc, *w_out, *norm2_g, *w_ffn_in, *w_ffn_out, *norm_f_g;
    float* out;
    bf16_t *wt_in;
    bf16_t *wt_p;
    bf16_t *wt_out;
    bf16_t *wt_fi;
    bf16_t *wt_fo;
    float *mod;
    float *lb;
    float2 *rope;
    bf16_t *h;
    bf16_t *h2;
    bf16_t *z;
    bf16_t *o;
    unsigned *bar;
};

__device__ __forceinline__ float bf2f(bf16_t h) { return __uint_as_float(((unsigned)h) << 16); }
__device__ __forceinline__ bf16_t f2bf(float f) { unsigned u = __float_as_uint(f); u += 0x7fffu + ((u >> 16) & 1u); return (bf16_t)(u >> 16); }
__device__ __forceinline__ unsigned pk2(float lo, float hi) { return (unsigned)f2bf(lo) | ((unsigned)f2bf(hi) << 16); }
typedef __bf16 bf16x2_t __attribute__((ext_vector_type(2)));
typedef float f32x2_t __attribute__((ext_vector_type(2)));
__device__ __forceinline__ unsigned cvt_pk_bf16(float lo, float hi) { const f32x2_t f = {lo, hi}; const bf16x2_t v = __builtin_convertvector(f, bf16x2_t); return __builtin_bit_cast(unsigned, v); }
__device__ __forceinline__ float sigmoidf_(float x) { return __builtin_amdgcn_rcpf(1.0f + __expf(-x)); }
__device__ __forceinline__ float clampf(float x, float lo, float hi) { return fminf(fmaxf(x, lo), hi); }

namespace pg8 {
constexpr int BM = 256, BK = 64, HALF = 128, HTB = HALF * BK * 2, STAGE_BYTES = 8 * HTB, NXCD = 8, WGM = 8;
__host__ __device__ __forceinline__ int lds_byte(int r, int c) { const int st = (r >> 4) * 2 + (c >> 5), rr = r & 15, cc = c & 31, ob = rr * 64 + cc * 2; return st * 1024 + (ob ^ (((ob >> 9) & 1) << 5)); }
__host__ __device__ __forceinline__ void stage_rc(int b, int& R, int& C) { const int st = b / 1024, sb = b % 1024, swz = sb ^ (((sb >> 9) & 1) << 5); R = (st >> 1) * 16 + swz / 64; C = (st & 1) * 32 + (swz % 64) / 2; }
__host__ __device__ __forceinline__ int perm32(int rho) { const int n = rho >> 4, i = rho & 15; return 8 * (i >> 2) + 4 * n + (i & 3); }

struct Unit { int pm, pn; };
struct Gemm { const bf16_t* A; const bf16_t* Bt; int lda, ldb, K; };

struct StaticOrder {
    int nM, nN, nwg, G, c;
    __device__ void init(int M, int N, int G_, int c_) { nM = M / BM; nN = N / BM; nwg = nM * nN; G = G_; c = c_; }
    __device__ bool next(int i, Unit& u) const {
        const long L = (long)i * G + c; if (L >= nwg) return false;
        int wgid = (int)L; { const int q = nwg / NXCD, r = nwg % NXCD, xcd = wgid % NXCD, off = wgid / NXCD; wgid = (xcd < r ? xcd * (q + 1) : r * (q + 1) + (xcd - r) * q) + off; }
        const int nig = WGM * nN, gid = wgid / nig, fm = gid * WGM, gsz = (nM - fm) < WGM ? (nM - fm) : WGM;
        u.pm = fm + ((wgid % nig) % gsz); u.pn = (wgid % nig) / gsz; return true;
    }
};
struct ProjOrder {
    StaticOrder base;
    __device__ bool next(int i, Unit& u) const { if (!base.next(i, u)) return false; u.pn = (u.pn + 22) % 36; return true; }
};
struct MergeOrder {
    StaticOrder base;
    __device__ bool next(int i, Unit& u) const { Unit t; if (!base.next(i / 3, t)) return false; const int br = i % 3; u.pm = br * (MH / BM) + t.pm; u.pn = br * (D / BM) + t.pn; return true; }
};

typedef f32x4 Acc[2][2][4][2];
__device__ __forceinline__ void zero_acc(Acc& acc) {
#pragma unroll
    for (int a = 0; a < 2; ++a)
#pragma unroll
        for (int b = 0; b < 2; ++b)
#pragma unroll
            for (int m = 0; m < 4; ++m)
#pragma unroll
                for (int n = 0; n < 2; ++n) acc[a][b][m][n] = (f32x4){0.f, 0.f, 0.f, 0.f};
}

struct EpiZ {
    static constexpr bool PERM = true;
    bf16_t* O; int ldc;
    __device__ __forceinline__ void operator()(Acc& acc, const Unit& u, int wr, int wc, int fr, int fq) const {
        const int row0 = u.pm * BM + wr * 64 + fr, col0 = u.pn * BM + wc * 32 + 8 * fq;
#pragma unroll
        for (int ai = 0; ai < 2; ++ai)
#pragma unroll
            for (int m = 0; m < 4; ++m) { bf16_t* rowp = O + (size_t)(row0 + ai * HALF + m * 16) * ldc + col0;
#pragma unroll
                for (int bj = 0; bj < 2; ++bj) { f32x4 v0 = acc[ai][bj][m][0], v1 = acc[ai][bj][m][1];
                    if (u.pn < 2) {
#pragma unroll
                        for (int j = 0; j < 4; ++j) { v0[j] *= sigmoidf_(v0[j]); v1[j] *= sigmoidf_(v1[j]); } }
                    else if ((u.pn >= 2 && u.pn < 6) || (u.pn >= 22 && u.pn < 34)) {
#pragma unroll
                        for (int j = 0; j < 4; ++j) { v0[j] = sigmoidf_(v0[j]); v1[j] = sigmoidf_(v1[j]); } }
                    u32x4 w; w.x = cvt_pk_bf16(v0[0], v0[1]); w.y = cvt_pk_bf16(v0[2], v0[3]); w.z = cvt_pk_bf16(v1[0], v1[1]); w.w = cvt_pk_bf16(v1[2], v1[3]);
                    *(u32x4*)(rowp + bj * HALF) = w; } }
        zero_acc(acc);
    }
};
struct EpiAct {
    static constexpr bool PERM = true;
    bf16_t* O; int ldc;
    __device__ __forceinline__ void operator()(Acc& acc, const Unit& u, int wr, int wc, int fr, int fq) const {
        const int row0 = u.pm * BM + wr * 64 + fr, col0 = u.pn * HALF + wc * 32 + 8 * fq;
#pragma unroll
        for (int ai = 0; ai < 2; ++ai)
#pragma unroll
            for (int m = 0; m < 4; ++m) { bf16_t* rowp = O + (size_t)(row0 + ai * HALF + m * 16) * ldc + col0;
                float r[8];
#pragma unroll
                for (int n = 0; n < 2; ++n)
#pragma unroll
                    for (int j = 0; j < 4; ++j) { const float g = acc[ai][0][m][n][j], up = acc[ai][1][m][n][j]; r[n * 4 + j] = g * sigmoidf_(g) * up; }
                u32x4 w; w.x = cvt_pk_bf16(r[0], r[1]); w.y = cvt_pk_bf16(r[2], r[3]); w.z = cvt_pk_bf16(r[4], r[5]); w.w = cvt_pk_bf16(r[6], r[7]);
                *(u32x4*)rowp = w; }
        zero_acc(acc);
    }
};
struct EpiRes {
    static constexpr bool PERM = true;
    const float* xin; float* xout; const float* gm;
    __device__ __forceinline__ void operator()(Acc& acc, const Unit& u, int wr, int wc, int fr, int fq) const {
        const int row0 = u.pm * BM + wr * 64 + fr, col0 = u.pn * BM + wc * 32 + 8 * fq;
        const float* gb = gm + (size_t)((u.pm * BM) / SEQ) * (6 * D);
        f32x4 gv[2][2];
#pragma unroll
        for (int bj = 0; bj < 2; ++bj)
#pragma unroll
            for (int n = 0; n < 2; ++n) gv[bj][n] = *(const f32x4*)(gb + col0 + bj * HALF + n * 4);
#pragma unroll
        for (int ai = 0; ai < 2; ++ai) {
            f32x4 xi[4][2][2];
#pragma unroll
            for (int m = 0; m < 4; ++m) { const size_t off = (size_t)(row0 + ai * HALF + m * 16) * D + col0;
#pragma unroll
                for (int bj = 0; bj < 2; ++bj)
#pragma unroll
                    for (int n = 0; n < 2; ++n) xi[m][bj][n] = *(const f32x4*)(xin + off + bj * HALF + n * 4); }
#pragma unroll
            for (int m = 0; m < 4; ++m) { const size_t off = (size_t)(row0 + ai * HALF + m * 16) * D + col0;
#pragma unroll
                for (int bj = 0; bj < 2; ++bj)
#pragma unroll
                    for (int n = 0; n < 2; ++n) *(f32x4*)(xout + off + bj * HALF + n * 4) = xi[m][bj][n] + gv[bj][n] * acc[ai][bj][m][n]; }
        }
        zero_acc(acc);
    }
};
struct EpiMerge {
    static constexpr bool PERM = true;
    const bf16_t* z; bf16_t* O;
    __device__ __forceinline__ void operator()(Acc& acc, const Unit& u, int wr, int wc, int fr, int fq) const {
        const int br = u.pm / (MH / BM), pm = u.pm - br * (MH / BM), pn = u.pn - br * (D / BM);
        const int row0 = pm * BM + wr * 64 + fr, col0 = pn * BM + wc * 32 + 8 * fq;
        const bf16_t* zg = z + ZG_A + br * D + col0;
#pragma unroll
        for (int ai = 0; ai < 2; ++ai) {
            u32x4 g0[4][2], g1[4][2];
#pragma unroll
            for (int m = 0; m < 4; ++m) { const size_t row = (size_t)(row0 + ai * HALF + m * 16);
#pragma unroll
                for (int bj = 0; bj < 2; ++bj) { g0[m][bj] = *(const u32x4*)(zg + row * NZ + bj * HALF);
                    if (br < 2) g1[m][bj] = *(const u32x4*)(zg + row * NZ + D + bj * HALF); } }
#pragma unroll
            for (int m = 0; m < 4; ++m) { const size_t row = (size_t)(row0 + ai * HALF + m * 16);
#pragma unroll
                for (int bj = 0; bj < 2; ++bj) {
                    float s[8];
                    if (br < 2) {
#pragma unroll
                        for (int e = 0; e < 4; ++e) {
                            const float a0 = __uint_as_float(g0[m][bj][e] << 16), a1 = __uint_as_float(g0[m][bj][e] & 0xffff0000u);
                            const float b0 = __uint_as_float(g1[m][bj][e] << 16), b1 = __uint_as_float(g1[m][bj][e] & 0xffff0000u);
                            s[2 * e] = a0 * __builtin_amdgcn_rcpf(fmaxf(b0, 1e-30f)); s[2 * e + 1] = a1 * __builtin_amdgcn_rcpf(fmaxf(b1, 1e-30f)); }
#pragma unroll
                        for (int n = 0; n < 2; ++n)
#pragma unroll
                            for (int j = 0; j < 4; ++j) acc[ai][bj][m][n][j] *= s[n * 4 + j];
                    } else {
#pragma unroll
                        for (int e = 0; e < 4; ++e) { s[2 * e] = __uint_as_float(g0[m][bj][e] << 16); s[2 * e + 1] = __uint_as_float(g0[m][bj][e] & 0xffff0000u); }
                        const f32x4 v0 = acc[ai][bj][m][0], v1 = acc[ai][bj][m][1];
                        u32x4 w; w.x = cvt_pk_bf16(v0[0] * s[0], v0[1] * s[1]); w.y = cvt_pk_bf16(v0[2] * s[2], v0[3] * s[3]);
                        w.z = cvt_pk_bf16(v1[0] * s[4], v1[1] * s[5]); w.w = cvt_pk_bf16(v1[2] * s[6], v1[3] * s[7]);
                        *(u32x4*)(O + row * D + col0 + bj * HALF) = w;
                        acc[ai][bj][m][0] = (f32x4){0.f, 0.f, 0.f, 0.f}; acc[ai][bj][m][1] = (f32x4){0.f, 0.f, 0.f, 0.f};
                    } } }
        }
    }
};

template <class Epi, class Sched>
__device__ __forceinline__ void gemm_phase(LAS unsigned char* lds, const Gemm g, const Sched& S, const Epi& E) {
    int tid_ = threadIdx.x; asm volatile("" : "+v"(tid_));
    const int tid = tid_, wid = __builtin_amdgcn_readfirstlane(tid >> 6), lane = tid & 63, wr = wid >> 2, wc = wid & 3, fr = lane & 15, fq = lane >> 4;
    const int K = g.K, nt = K / BK;
    unsigned voffA[2], voffB[2];
#pragma unroll
    for (int i = 0; i < 2; ++i) { int R, C; stage_rc(tid * 16 + i * 8192, R, C); const int Rb = Epi::PERM ? ((R & ~31) + perm32(R & 31)) : R;
        voffA[i] = (unsigned)(R * g.lda + C) * 2u; voffB[i] = (unsigned)(Rb * g.ldb + C) * 2u; }
    const size_t kstep = (size_t)(BK * 2);
    const size_t hstepA = (size_t)HALF * g.lda * 2, hstepB = (size_t)HALF * g.ldb * 2;
    const size_t tstepA = 2 * hstepA, tstepB = 2 * hstepB;
    const unsigned ldsw = (unsigned)wid * 1024u;
    const int aoff = lds_byte(wr * 64 + fr, fq * 8), boff = lds_byte(wc * 32 + fr, fq * 8);
#define PG8_SA(b, h) (((b) * 2 + (h)) * HTB)
#define PG8_SB(b, h) ((4 + (b) * 2 + (h)) * HTB)
#define PG8_STAGE(bufoff, gbase, voff) do { _Pragma("unroll") for (int _i = 0; _i < 2; ++_i) \
        __builtin_amdgcn_global_load_lds((const unsigned*)((const char*)(gbase) + (voff)[_i]), (LAS unsigned*)(lds + (bufoff) + ldsw + _i * 8192), 16, 0, 0); } while (0)
#define PG8_LDA(dst, b, h) do { _Pragma("unroll") for (int m = 0; m < 4; ++m) _Pragma("unroll") for (int k = 0; k < 2; ++k) dst[m][k] = *(const LAS bf16x8*)(lds + PG8_SA(b, h) + aoff + m * 2048 + k * 1024); } while (0)
#define PG8_LDB(dst, b, h) do { _Pragma("unroll") for (int n = 0; n < 2; ++n) _Pragma("unroll") for (int k = 0; k < 2; ++k) dst[n][k] = *(const LAS bf16x8*)(lds + PG8_SB(b, h) + boff + n * 2048 + k * 1024); } while (0)
#define PG8_MMA(ai, bj, At, Bt) do { __builtin_amdgcn_s_setprio(1); _Pragma("unroll") for (int m = 0; m < 4; ++m) _Pragma("unroll") for (int n = 0; n < 2; ++n) _Pragma("unroll") for (int k = 0; k < 2; ++k) \
        acc[ai][bj][m][n] = __builtin_amdgcn_mfma_f32_16x16x32_bf16(Bt[n][k], At[m][k], acc[ai][bj][m][n], 0, 0, 0); __builtin_amdgcn_s_setprio(0); } while (0)
#define PG8_WAIT_V(n) asm volatile("s_waitcnt vmcnt(" #n ")" ::: "memory")
#define PG8_WAIT_L(n) asm volatile("s_waitcnt lgkmcnt(" #n ")" ::: "memory")
#define PG8_BAR __builtin_amdgcn_s_barrier()
#define PG8_SCHED __builtin_amdgcn_sched_barrier(0)
    Unit cur, nxt; int ui = 0;
    if (!S.next(0, cur)) return;
    Acc acc; zero_acc(acc);
    bf16x8 At[4][2], B0[2][2], B1[2][2];
    const char* cA = (const char*)g.A + (size_t)cur.pm * tstepA; const char* cB = (const char*)g.Bt + (size_t)cur.pn * tstepB;
    PG8_STAGE(PG8_SB(0, 0), cB, voffB); PG8_STAGE(PG8_SA(0, 0), cA, voffA); PG8_STAGE(PG8_SB(0, 1), cB + hstepB, voffB); PG8_STAGE(PG8_SA(0, 1), cA + hstepA, voffA);
    if (wr == 1) PG8_BAR;
    PG8_WAIT_V(4); PG8_BAR;
    PG8_STAGE(PG8_SB(1, 0), cB + kstep, voffB); PG8_STAGE(PG8_SA(1, 0), cA + kstep, voffA); PG8_STAGE(PG8_SB(1, 1), cB + hstepB + kstep, voffB);
    PG8_WAIT_V(6); PG8_BAR;
    for (;;) {
        const bool has_next = S.next(ui + 1, nxt);
        const char* nA = has_next ? (const char*)g.A + (size_t)nxt.pm * tstepA : cA; const char* nB = has_next ? (const char*)g.Bt + (size_t)nxt.pn * tstepB : cB;
        for (int t = 0; t < nt; t += 2) {
            const bool last = (t == nt - 2);
            const char* a1 = cA + (size_t)(t + 1) * kstep;
            const char* a2 = last ? nA : cA + (size_t)(t + 2) * kstep; const char* b2 = last ? nB : cB + (size_t)(t + 2) * kstep;
            const char* a3 = a2 + kstep; const char* b3 = b2 + kstep;
            PG8_LDB(B0, 0, 0); PG8_SCHED; PG8_LDA(At, 0, 0); PG8_STAGE(PG8_SA(1, 1), a1 + hstepA, voffA);
            PG8_WAIT_L(8); PG8_BAR; PG8_WAIT_L(0); PG8_MMA(0, 0, At, B0); PG8_BAR; PG8_SCHED;
            PG8_LDB(B1, 0, 1); PG8_STAGE(PG8_SB(0, 0), b2, voffB);
            PG8_BAR; PG8_WAIT_L(0); PG8_MMA(0, 1, At, B1); PG8_BAR;
            PG8_LDA(At, 0, 1); PG8_STAGE(PG8_SA(0, 0), a2, voffA);
            PG8_BAR; PG8_WAIT_L(0); PG8_MMA(1, 0, At, B0); PG8_BAR; PG8_SCHED;
            PG8_STAGE(PG8_SB(0, 1), b2 + hstepB, voffB);
            PG8_WAIT_V(6); PG8_BAR; PG8_MMA(1, 1, At, B1); PG8_BAR;
            PG8_LDB(B0, 1, 0); PG8_SCHED; PG8_LDA(At, 1, 0); PG8_STAGE(PG8_SA(0, 1), a2 + hstepA, voffA);
            PG8_WAIT_L(8); PG8_BAR; PG8_WAIT_L(0); PG8_MMA(0, 0, At, B0); PG8_BAR; PG8_SCHED;
            PG8_LDB(B1, 1, 1); PG8_STAGE(PG8_SB(1, 0), b3, voffB);
            PG8_BAR; PG8_WAIT_L(0); PG8_MMA(0, 1, At, B1); PG8_BAR;
            PG8_LDA(At, 1, 1); PG8_STAGE(PG8_SA(1, 0), a3, voffA);
            PG8_BAR; PG8_WAIT_L(0); PG8_MMA(1, 0, At, B0); PG8_BAR; PG8_SCHED;
            PG8_STAGE(PG8_SB(1, 1), b3 + hstepB, voffB);
            PG8_WAIT_V(6); PG8_BAR; PG8_MMA(1, 1, At, B1); PG8_BAR;
        }
        E(acc, cur, wr, wc, fr, fq);
        if (!has_next) break;
        cur = nxt; cA = nA; cB = nB; ++ui;
    }
    PG8_WAIT_V(0);
    if (wr == 0) PG8_BAR;
    PG8_BAR;
#undef PG8_SA
#undef PG8_SB
#undef PG8_STAGE
#undef PG8_LDA
#undef PG8_LDB
#undef PG8_MMA
#undef PG8_WAIT_V
#undef PG8_WAIT_L
#undef PG8_BAR
#undef PG8_SCHED
}
}

__device__ void phase_prologue(const Params& p, LAS unsigned char* lds) {
    int tid_ = threadIdx.x; asm volatile("" : "+v"(tid_)); const int tid = tid_;
    for (int i = blockIdx.x * 512 + tid; i < SEQ * 32; i += gridDim.x * 512) {
        const int pos = i >> 5, fi = i & 31;
        const float invf = exp2f(-(float)fi * (13.287712379549449f / 32.0f));
        const float ang = (float)pos * invf;
        double rev = (double)ang * 0.15915494309189535;
        rev -= rint(rev);
        const float rf = (float)rev;
        p.rope[i] = make_float2(__builtin_amdgcn_cosf(rf), __builtin_amdgcn_sinf(rf));
    }
    if (blockIdx.x == 0) {
        const int i = tid;
        float lg[DEPTH], mx = -1e30f;
#pragma unroll
        for (int l = 0; l < DEPTH; ++l) { lg[l] = p.lb_logits[l * 512 + i]; mx = fmaxf(mx, lg[l]); }
        float s = 0.f;
#pragma unroll
        for (int l = 0; l < DEPTH; ++l) { lg[l] = expf(lg[l] - mx); s += lg[l]; }
        const float inv = 1.0f / s; const float p0 = lg[0] * inv; float cum = 0.f;
#pragma unroll
        for (int l = 0; l < DEPTH; ++l) { cum += lg[l] * inv; p.lb[l * 512 + i] = fmaxf(cum - p0, 0.0f); }
    }
    LAS float* cact = (LAS float*)lds;
    LAS float* red = (LAS float*)(lds + 65536);
    for (int item = blockIdx.x; item < DEPTH * 48; item += gridDim.x) {
        const int l = item / 48, cb = item % 48;
        for (int i = tid; i < BATCH * D; i += 512) { const float c = p.c[i]; cact[i] = c * sigmoidf_(c); }
        __syncthreads();
        const int col = tid & 127, kq = tid >> 7;
        float acc[16];
#pragma unroll
        for (int b = 0; b < 16; ++b) acc[b] = 0.f;
        const float* wp = p.w_ada + ((size_t)l * D + kq * 256) * (6 * D) + cb * 128 + col;
        for (int k = 0; k < 256; k += 4) {
            const float w0 = wp[(size_t)k * (6 * D)], w1 = wp[(size_t)(k + 1) * (6 * D)], w2 = wp[(size_t)(k + 2) * (6 * D)], w3 = wp[(size_t)(k + 3) * (6 * D)];
#pragma unroll
            for (int b = 0; b < 16; ++b) { const f32x4 cv = *(const LAS f32x4*)(cact + b * D + kq * 256 + k); acc[b] += cv[0] * w0 + cv[1] * w1 + cv[2] * w2 + cv[3] * w3; }
        }
#pragma unroll
        for (int b = 0; b < 16; ++b) red[(kq * 16 + b) * 128 + col] = acc[b];
        __syncthreads();
        for (int e = tid; e < 16 * 128; e += 512) {
            const int b = e >> 7, cc = e & 127;
            const float s = red[(0 * 16 + b) * 128 + cc] + red[(1 * 16 + b) * 128 + cc] + red[(2 * 16 + b) * 128 + cc] + red[(3 * 16 + b) * 128 + cc];
            p.mod[((size_t)l * BATCH + b) * (6 * D) + cb * 128 + cc] = s + p.b_ada[l * 6 * D + cb * 128 + cc];
        }
        __syncthreads();
    }
}

struct ConvTile { const float* src; int ldsrc; bf16_t* dst; int K; int k0; int n0; int kind; const float* wa; };
__device__ __forceinline__ int conv_srccol(int kind, int n) {
    if (kind == 1) return n < 5632 ? n : n < 8704 ? n + 32 : -2;
    if (kind == 2) { const int pn = n >> 8, bj = (n >> 7) & 1, ii = n & 127; return bj * DFF + pn * 128 + ii; }
    return n;
}
__device__ __forceinline__ ConvTile conv_decode(const Params& p, int l, int t) {
    constexpr int T_IN = 16 * 144, T_P = 3 * 8 * 16, T_OUT = 16 * 16, T_FI = 16 * 88;
    int i = t; ConvTile c;
    if (i < T_IN) { c = ConvTile{p.w_in + (size_t)l * D * NIN, NIN, p.wt_in, D, (i & 15) * 64, (i >> 4) * 64, 1, p.w_alpha + (size_t)l * 2 * 16 * 256}; return c; }
    i -= T_IN;
    if (i < T_P) { const int br = i / 128, r = i % 128;
        c = ConvTile{(br == 0 ? p.w_pa : br == 1 ? p.w_pb : p.w_pc) + (size_t)l * 512 * D, D, p.wt_p + (size_t)br * D * 512, 512, (r & 7) * 64, (r >> 3) * 64, 0, nullptr}; return c; }
    i -= T_P;
    if (i < T_OUT) { c = ConvTile{p.w_out + (size_t)l * D * D, D, p.wt_out, D, (i & 15) * 64, (i >> 4) * 64, 0, nullptr}; return c; }
    i -= T_OUT;
    if (i < T_FI) { c = ConvTile{p.w_ffn_in + (size_t)l * D * 2 * DFF, 2 * DFF, p.wt_fi, D, (i & 15) * 64, (i >> 4) * 64, 2, nullptr}; return c; }
    i -= T_FI;
    c = ConvTile{p.w_ffn_out + (size_t)l * DFF * D, D, p.wt_fo, DFF, (i % 44) * 64, (i / 44) * 64, 0, nullptr}; return c;
}
__device__ __forceinline__ void conv_load(const ConvTile& c, int tid, float (&v)[8]) {
    const int cidx = tid & 63;
    if (c.kind == 1 && c.n0 >= 8704) {
        const int fc = c.n0 + cidx - 8704, dr = fc >> 8, ch = fc & 255;
        float wa[16];
#pragma unroll
        for (int r = 0; r < 16; ++r) wa[r] = c.wa[(dr * 16 + r) * 256 + ch];
#pragma unroll
        for (int i = 0; i < 8; ++i) { const int r_ = (tid >> 6) + 8 * i; const float* sp = c.src + (size_t)(c.k0 + r_) * c.ldsrc + 5632 + dr * 16;
            float a = 0.f;
#pragma unroll
            for (int q = 0; q < 4; ++q) { const f32x4 t = *(const f32x4*)(sp + q * 4); a += t[0] * wa[q * 4] + t[1] * wa[q * 4 + 1] + t[2] * wa[q * 4 + 2] + t[3] * wa[q * 4 + 3]; }
            v[i] = a; }
        return;
    }
    const int col4 = (tid & 15) * 4; const int sc4 = conv_srccol(c.kind, c.n0 + col4);
#pragma unroll
    for (int i = 0; i < 2; ++i) { const int r = (tid >> 4) + 32 * i; const f32x4 t = *(const f32x4*)(c.src + (size_t)(c.k0 + r) * c.ldsrc + sc4);
        v[i * 4] = t[0]; v[i * 4 + 1] = t[1]; v[i * 4 + 2] = t[2]; v[i * 4 + 3] = t[3]; }
}
__device__ __forceinline__ void conv_to_lds(const ConvTile& c, int tid, LAS float* tile, const float (&v)[8]) {
    if (c.kind == 1 && c.n0 >= 8704) {
#pragma unroll
        for (int i = 0; i < 8; ++i) tile[((tid >> 6) + 8 * i) * 65 + (tid & 63)] = v[i];
    } else {
#pragma unroll
        for (int i = 0; i < 2; ++i)
#pragma unroll
            for (int j = 0; j < 4; ++j) tile[((tid >> 4) + 32 * i) * 65 + (tid & 15) * 4 + j] = v[i * 4 + j];
    }
}
__device__ void phase_conv(const Params& p, LAS unsigned char* lds, int l) {
    LAS float* tile = (LAS float*)lds;
    constexpr int TOT = 16 * 144 + 3 * 8 * 16 + 16 * 16 + 16 * 88 + 44 * 16;
    int tid_ = threadIdx.x; asm volatile("" : "+v"(tid_)); const int tid = tid_;
    int t = blockIdx.x;
    if (t >= TOT) return;
    ConvTile cur = conv_decode(p, l, t);
    float v[8]; conv_load(cur, tid, v);
    for (;;) {
        const int tn = t + gridDim.x; const bool has_next = tn < TOT;
        conv_to_lds(cur, tid, tile, v);
        ConvTile nxt = cur;
        if (has_next) { nxt = conv_decode(p, l, tn); conv_load(nxt, tid, v); }
        __syncthreads();
        {
            const int n = tid >> 3, kk = (tid & 7) * 8;
            float w[8];
#pragma unroll
            for (int j = 0; j < 8; ++j) w[j] = tile[(kk + j) * 65 + n];
            *(u32x4*)(cur.dst + (size_t)(cur.n0 + n) * cur.K + cur.k0 + kk) = (u32x4){cvt_pk_bf16(w[0], w[1]), cvt_pk_bf16(w[2], w[3]), cvt_pk_bf16(w[4], w[5]), cvt_pk_bf16(w[6], w[7])};
        }
        __syncthreads();
        if (!has_next) break;
        cur = nxt; t = tn;
    }
}

__device__ void phase_norm(const float* xg  , const float* gain, const float* modg  , int shoff, int scoff, bf16_t* h, int nrows) {
    int tid_ = threadIdx.x; asm volatile("" : "+v"(tid_));
    const int lane = tid_ & 63, wid = tid_ >> 6;
    f32x4 g[4];
#pragma unroll
    for (int i = 0; i < 4; ++i) g[i] = *(const f32x4*)(gain + lane * 4 + i * 256);
    for (int rg = blockIdx.x; rg < nrows / 16; rg += gridDim.x) {
        f32x4 v[2][4], sc[4], sh[4]; float ss[2] = {0.f, 0.f};
        const float* mb = modg + (size_t)((rg * 16) / SEQ) * (6 * D);
#pragma unroll
        for (int t = 0; t < 2; ++t) { const float* xr = xg + (size_t)(rg * 16 + t * 8 + wid) * D;
#pragma unroll
            for (int i = 0; i < 4; ++i) v[t][i] = *(const f32x4*)(xr + lane * 4 + i * 256); }
#pragma unroll
        for (int i = 0; i < 4; ++i) { sc[i] = *(const f32x4*)(mb + scoff + lane * 4 + i * 256); sh[i] = *(const f32x4*)(mb + shoff + lane * 4 + i * 256); }
#pragma unroll
        for (int t = 0; t < 2; ++t) {
#pragma unroll
            for (int i = 0; i < 4; ++i) ss[t] += v[t][i][0] * v[t][i][0] + v[t][i][1] * v[t][i][1] + v[t][i][2] * v[t][i][2] + v[t][i][3] * v[t][i][3];
#pragma unroll
            for (int m = 32; m >= 1; m >>= 1) ss[t] += __shfl_xor(ss[t], m); }
#pragma unroll
        for (int t = 0; t < 2; ++t) {
            const int row = rg * 16 + t * 8 + wid;
            const float rstd = rsqrtf(ss[t] * (1.0f / D) + 1e-6f);
#pragma unroll
            for (int i = 0; i < 4; ++i) { const int c = lane * 4 + i * 256;
                const f32x4 r = v[t][i] * rstd * g[i] * (sc[i] + 1.0f) + sh[i];
                *(u32x2*)(h + (size_t)row * D + c) = (u32x2){cvt_pk_bf16(r[0], r[1]), cvt_pk_bf16(r[2], r[3])}; }
        }
    }
}
__device__ void phase_final(const Params& p) {
    int tid_ = threadIdx.x; asm volatile("" : "+v"(tid_));
    const int lane = tid_ & 63, wid = tid_ >> 6;
    f32x4 g[4];
#pragma unroll
    for (int i = 0; i < 4; ++i) g[i] = *(const f32x4*)(p.norm_f_g + lane * 4 + i * 256);
    for (int rg = blockIdx.x; rg < BATCH * SEQ / 16; rg += gridDim.x) {
        f32x4 v[2][4]; float ss[2];
#pragma unroll
        for (int t = 0; t < 2; ++t) { const float* xr = p.out + (size_t)(rg * 16 + t * 8 + wid) * D;
#pragma unroll
            for (int i = 0; i < 4; ++i) v[t][i] = *(const f32x4*)(xr + lane * 4 + i * 256); }
#pragma unroll
        for (int t = 0; t < 2; ++t) { ss[t] = 0.f;
#pragma unroll
            for (int i = 0; i < 4; ++i) ss[t] += v[t][i][0] * v[t][i][0] + v[t][i][1] * v[t][i][1] + v[t][i][2] * v[t][i][2] + v[t][i][3] * v[t][i][3];
#pragma unroll
            for (int m = 32; m >= 1; m >>= 1) ss[t] += __shfl_xor(ss[t], m); }
#pragma unroll
        for (int t = 0; t < 2; ++t) { float* xr = p.out + (size_t)(rg * 16 + t * 8 + wid) * D;
            const float rstd = rsqrtf(ss[t] * (1.0f / D) + 1e-6f);
#pragma unroll
            for (int i = 0; i < 4; ++i) *(f32x4*)(xr + lane * 4 + i * 256) = v[t][i] * rstd * g[i]; }
    }
}

template <int DK, int DV, int MIX>
__device__ void scan_item(const Params& p, LAS unsigned char* lds, int layer, int bl, int head, int dir, int vhalf) {
    constexpr int TG = 512 / DK, TPG = 64 / TG;
    constexpr int TGV = 512 / DV, TPGV = 64 / TGV;
    constexpr int SQ = DK * 2 + 16, S64 = 144;
    constexpr int OFF_QT = 0, OFF_KT = OFF_QT + 64 * SQ, OFF_QS = OFF_KT + 64 * SQ, OFF_KL = OFF_QS + 64 * SQ, OFF_VT = OFF_KL + DK * S64,
                  OFF_P = OFF_VT + DV * S64, OFF_ST = OFF_P + 64 * S64, OFF_TOT = OFF_ST + DV * SQ, OFF_EL = OFF_TOT + TG * DK * 4,
                  OFF_RQ = OFF_EL + DK * 4, OFF_RK = OFF_RQ + 64 * DK * 2, OFF_RV = OFF_RK + 64 * DK * 2, OFF_RL = OFF_RV + 64 * DV * 2, OFF_END = OFF_RL + (MIX == 2 ? 64 * 128 : 0);
    static_assert(OFF_END <= LDS_MAIN, "lds");
    static_assert(OFF_RQ % 1024 == 0 || true, "");
    constexpr int NV = DV / 32;
    int tid_ = threadIdx.x; asm volatile("" : "+v"(tid_));
    const int tid = tid_, lane = tid & 63, wid = __builtin_amdgcn_readfirstlane(tid >> 6), fr = lane & 15, fq = lane >> 4;
    const int d = tid % DK, g = tid / DK, vv = tid % DV, gv = tid / DV;
    const bf16_t* zb = p.z + (size_t)(bl * SEQ) * NZ;
    int cbq, cbk, cbv;
    if (MIX == 0) { cbq = ZA_Q + head * 128; cbk = (dir ? ZA_FB : ZA_FF) + head * 128; cbv = ZA_I + head * 128 + vhalf * 64; }
    else if (MIX == 1) { cbq = ZB_Q + head * 64; cbk = ZB_K + head * 64; cbv = ZB_V + head * 128; }
    else { cbq = ZC_Q + head * 64; cbk = ZC_K + head * 64; cbv = ZC_V + head * 128; }
    float lbv = 0.f, oml = 1.f, gam = 1.f, bal = 0.f;
    if (MIX == 0) { lbv = p.lb[layer * 512 + head * 128 + d]; oml = 1.0f - lbv; }
    if (MIX == 1) { const int hh = dir ? 3 - head : head; gam = 1.0f - exp2f(-5.0f - (float)hh); }
    if (MIX == 2) bal = p.b_alpha[((size_t)layer * 2 + dir) * 256 + head * 64 + d];
    const int cbl = ZC_LG + dir * 256 + head * 64;
    float2 rin[TPG];
    if (MIX == 1) {
#pragma unroll
        for (int tt = 0; tt < TPG; ++tt) { const int ip = g * TPG + tt; rin[tt] = p.rope[(dir ? 63 - ip : ip) * 32 + (d & 31)]; }
    }
    f32x4 S[4];
#pragma unroll
    for (int q = 0; q < 4; ++q) S[q] = (f32x4){0.f, 0.f, 0.f, 0.f};
    for (int i = tid * 16; i < DV * SQ; i += 512 * 16) *(LAS u32x4*)(lds + OFF_ST + i) = (u32x4){0u, 0u, 0u, 0u};
    const int ti = wid & 3;
    const int tj0 = (wid >> 2) * 2;
    const int tv0 = (wid >> 2) * NV;

    auto stage_rows = [&](int cn, int ldsoff, int colbase, int rbshift  ) {
        const int n = dir ? 31 - cn : cn;
        const bf16_t* zc = zb + (size_t)(n * 64) * NZ + colbase;
        const int rpw = 1024 >> rbshift, nwl = 64 / rpw, l16 = (1 << rbshift) >> 4;
        for (int wl = wid; wl < nwl; wl += 8) {
            const int row = wl * rpw + lane / l16, c16 = lane % l16; const int tk = dir ? 63 - row : row;
            __builtin_amdgcn_global_load_lds((const unsigned*)(zc + (size_t)tk * NZ + c16 * 8), (LAS unsigned*)(lds + ldsoff + wl * 1024), 16, 0, 0);
        }
    };
    constexpr int RBQ = (DK == 128) ? 8 : 7, RBV = (DV == 128) ? 8 : 7;
    stage_rows(0, OFF_RQ, cbq, RBQ); stage_rows(0, OFF_RK, cbk, RBQ); stage_rows(0, OFF_RV, cbv, RBV);
    if (MIX == 2) stage_rows(0, OFF_RL, cbl, 7);
    asm volatile("s_waitcnt vmcnt(0)" ::: "memory");
    __syncthreads();

    for (int cn = 0; cn < 32; ++cn) {
        const int n = dir ? 31 - cn : cn;
        float qv[TPG], kv[TPG], pl[TPG], sl[TPG];
        {
            float f[TPG];
            float2 rcs[TPG];
            if (MIX == 1) {
                const float2 cb = p.rope[(n * 64) * 32 + (d & 31)];
#pragma unroll
                for (int tt = 0; tt < TPG; ++tt) rcs[tt] = make_float2(cb.x * rin[tt].x - cb.y * rin[tt].y, cb.y * rin[tt].x + cb.x * rin[tt].y);
            }
#pragma unroll
            for (int tt = 0; tt < TPG; ++tt) {
                const int ip = g * TPG + tt;
                if (MIX == 0) {
                    qv[tt] = bf2f(*(const LAS bf16_t*)(lds + OFF_RQ + ip * (DK * 2) + d * 2));
                    const float sg = bf2f(*(const LAS bf16_t*)(lds + OFF_RK + ip * (DK * 2) + d * 2));
                    f[tt] = fmaxf(lbv + oml * sg, 1e-30f); kv[tt] = oml * (1.0f - sg);
                } else if (MIX == 1) {
                    const int dl = d & 31;
                    const float q1 = bf2f(*(const LAS bf16_t*)(lds + OFF_RQ + ip * (DK * 2) + dl * 2)), q2 = bf2f(*(const LAS bf16_t*)(lds + OFF_RQ + ip * (DK * 2) + dl * 2 + 64));
                    const float k1 = bf2f(*(const LAS bf16_t*)(lds + OFF_RK + ip * (DK * 2) + dl * 2)), k2 = bf2f(*(const LAS bf16_t*)(lds + OFF_RK + ip * (DK * 2) + dl * 2 + 64));
                    const float2 cs = rcs[tt];
                    if (d < 32) { qv[tt] = q1 * cs.x - q2 * cs.y; kv[tt] = (k1 * cs.x - k2 * cs.y) * 0.125f; }
                    else        { qv[tt] = q1 * cs.y + q2 * cs.x; kv[tt] = (k1 * cs.y + k2 * cs.x) * 0.125f; }
                    f[tt] = gam;
                } else {
                    qv[tt] = bf2f(*(const LAS bf16_t*)(lds + OFF_RQ + ip * (DK * 2) + d * 2)) * 0.125f; kv[tt] = bf2f(*(const LAS bf16_t*)(lds + OFF_RK + ip * (DK * 2) + d * 2));
                    const float logit = bal + bf2f(*(const LAS bf16_t*)(lds + OFF_RL + ip * 128 + d * 2));
                    const float lg = (fminf(logit, 0.f) - __logf(1.0f + __expf(-fabsf(logit)))) * (1.0f / 16.0f);
                    f[tt] = __expf(lg);
                }
            }
            pl[0] = f[0];
#pragma unroll
            for (int tt = 1; tt < TPG; ++tt) pl[tt] = pl[tt - 1] * f[tt];
            sl[TPG - 1] = 1.0f;
#pragma unroll
            for (int tt = TPG - 2; tt >= 0; --tt) sl[tt] = sl[tt + 1] * f[tt + 1];
        }
        ((LAS float*)(lds + OFF_TOT))[g * DK + d] = pl[TPG - 1];
        __syncthreads();
        if (cn + 1 < 32) { stage_rows(cn + 1, OFF_RQ, cbq, RBQ); stage_rows(cn + 1, OFF_RK, cbk, RBQ); if (MIX == 2) stage_rows(cn + 1, OFF_RL, cbl, 7); }
        {
            unsigned vp[TPGV / 2];
#pragma unroll
            for (int tt = 0; tt < TPGV; tt += 2) { const int ip = gv * TPGV + tt;
                vp[tt >> 1] = (unsigned)*(const LAS bf16_t*)(lds + OFF_RV + ip * (DV * 2) + vv * 2) | ((unsigned)*(const LAS bf16_t*)(lds + OFF_RV + (ip + 1) * (DV * 2) + vv * 2) << 16); }
            float H1 = 1.f, H2 = 1.f, R = 1.f, Fh = 1.f, Gl = 1.f, Gh = 1.f;
#pragma unroll
            for (int gg = 0; gg < TG; ++gg) { const float t = ((LAS float*)(lds + OFF_TOT))[gg * DK + d];
                if (gg < TG / 2) { H1 *= t; if (gg >= g) R *= t; if (gg > g) Gl *= t; }
                else { H2 *= t; if (gg < g) Fh *= t; if (gg > g) Gh *= t; } }
            const float Fg = (g < TG / 2) ? __builtin_amdgcn_rcpf(fmaxf(R, 1e-30f)) : Fh;
            const float Gg = (g < TG / 2) ? Gl : Gh * __builtin_amdgcn_rcpf(fmaxf(H2, 1e-30f));
            if (g == 0) ((LAS float*)(lds + OFF_EL))[d] = H1 * H2;
            unsigned klp[TPG / 2];
#pragma unroll
            for (int tt = 0; tt < TPG; tt += 2) {
                const int ip = g * TPG + tt;
                const float qa = qv[tt] * (pl[tt] * Fg), qb = qv[tt + 1] * (pl[tt + 1] * Fg);
                const float ka = kv[tt] * (sl[tt] * Gg), kb = kv[tt + 1] * (sl[tt + 1] * Gg);
                const unsigned wq = cvt_pk_bf16(qa, qb), wk = cvt_pk_bf16(ka, kb), ws = cvt_pk_bf16(qa * H1, qb * H1);
                *(LAS bf16_t*)(lds + OFF_QT + ip * SQ + d * 2) = (bf16_t)wq; *(LAS bf16_t*)(lds + OFF_QT + (ip + 1) * SQ + d * 2) = (bf16_t)(wq >> 16);
                *(LAS bf16_t*)(lds + OFF_KT + ip * SQ + d * 2) = (bf16_t)wk; *(LAS bf16_t*)(lds + OFF_KT + (ip + 1) * SQ + d * 2) = (bf16_t)(wk >> 16);
                *(LAS bf16_t*)(lds + OFF_QS + ip * SQ + d * 2) = (bf16_t)ws; *(LAS bf16_t*)(lds + OFF_QS + (ip + 1) * SQ + d * 2) = (bf16_t)(ws >> 16);
                klp[tt >> 1] = cvt_pk_bf16(ka * H2, kb * H2);
            }
#pragma unroll
            for (int q = 0; q < TPG / 8; ++q) *(LAS u32x4*)(lds + OFF_KL + d * S64 + (g * TPG + q * 8) * 2) = (u32x4){klp[q * 4], klp[q * 4 + 1], klp[q * 4 + 2], klp[q * 4 + 3]};
#pragma unroll
            for (int q = 0; q < TPGV / 8; ++q) *(LAS u32x4*)(lds + OFF_VT + vv * S64 + (gv * TPGV + q * 8) * 2) = (u32x4){vp[q * 4], vp[q * 4 + 1], vp[q * 4 + 2], vp[q * 4 + 3]};
        }
        __syncthreads();
        if (cn + 1 < 32) stage_rows(cn + 1, OFF_RV, cbv, RBV);
        f32x4 oa[NV];
        {
            f32x4 sc[2] = {(f32x4){0.f, 0.f, 0.f, 0.f}, (f32x4){0.f, 0.f, 0.f, 0.f}};
#pragma unroll
            for (int q = 0; q < NV; ++q) oa[q] = (f32x4){0.f, 0.f, 0.f, 0.f};
#pragma unroll
            for (int ks = 0; ks < DK / 32; ++ks) {
                const bf16x8 bq = *(const LAS bf16x8*)(lds + OFF_QT + (ti * 16 + fr) * SQ + ks * 64 + fq * 16);
#pragma unroll
                for (int jj = 0; jj < 2; ++jj) { const bf16x8 ak = *(const LAS bf16x8*)(lds + OFF_KT + ((tj0 + jj) * 16 + fr) * SQ + ks * 64 + fq * 16);
                    sc[jj] = __builtin_amdgcn_mfma_f32_16x16x32_bf16(ak, bq, sc[jj], 0, 0, 0); }
                const bf16x8 bs = *(const LAS bf16x8*)(lds + OFF_QS + (ti * 16 + fr) * SQ + ks * 64 + fq * 16);
#pragma unroll
                for (int q = 0; q < NV; ++q) { const bf16x8 as = *(const LAS bf16x8*)(lds + OFF_ST + ((tv0 + q) * 16 + fr) * SQ + ks * 64 + fq * 16);
                    oa[q] = __builtin_amdgcn_mfma_f32_16x16x32_bf16(as, bs, oa[q], 0, 0, 0); }
            }
            const int ipc = ti * 16 + fr;
#pragma unroll
            for (int jj = 0; jj < 2; ++jj) { const int jp0 = (tj0 + jj) * 16 + fq * 4; float m[4];
#pragma unroll
                for (int r = 0; r < 4; ++r) { const int jp = jp0 + r; const bool keep = dir ? (jp < ipc) : (jp <= ipc); m[r] = keep ? sc[jj][r] : 0.f; }
                *(LAS u32x2*)(lds + OFF_P + ipc * S64 + jp0 * 2) = (u32x2){cvt_pk_bf16(m[0], m[1]), cvt_pk_bf16(m[2], m[3])}; }
        }
        asm volatile("s_waitcnt vmcnt(0)" ::: "memory");
        __syncthreads();
        {
#pragma unroll
            for (int ks = 0; ks < 2; ++ks) {
                const bf16x8 bp = *(const LAS bf16x8*)(lds + OFF_P + (ti * 16 + fr) * S64 + ks * 64 + fq * 16);
#pragma unroll
                for (int q = 0; q < NV; ++q) { const bf16x8 av = *(const LAS bf16x8*)(lds + OFF_VT + ((tv0 + q) * 16 + fr) * S64 + ks * 64 + fq * 16);
                    oa[q] = __builtin_amdgcn_mfma_f32_16x16x32_bf16(av, bp, oa[q], 0, 0, 0); }
            }
            const int ip = ti * 16 + fr; const int tk = dir ? 63 - ip : ip;
            bf16_t* op = p.o + ((size_t)(dir * 3 + MIX) * MH + bl * SEQ + n * 64 + tk) * 512 + head * 128 + vhalf * 64;
#pragma unroll
            for (int q = 0; q < NV; ++q) *(u32x2*)(op + (tv0 + q) * 16 + fq * 4) = (u32x2){cvt_pk_bf16(oa[q][0], oa[q][1]), cvt_pk_bf16(oa[q][2], oa[q][3])};
        }
#pragma unroll
        for (int q = 0; q < 4; ++q) {
            const int tix = wid * 4 + q, td = tix / (DV / 16), tv = tix % (DV / 16);
            const f32x4 el = *(const LAS f32x4*)(lds + OFF_EL + (td * 16 + fq * 4) * 4);
            S[q] *= el;
#pragma unroll
            for (int ks = 0; ks < 2; ++ks) {
                const bf16x8 ak = *(const LAS bf16x8*)(lds + OFF_KL + (td * 16 + fr) * S64 + ks * 64 + fq * 16);
                const bf16x8 bv = *(const LAS bf16x8*)(lds + OFF_VT + (tv * 16 + fr) * S64 + ks * 64 + fq * 16);
                S[q] = __builtin_amdgcn_mfma_f32_16x16x32_bf16(ak, bv, S[q], 0, 0, 0);
            }
            *(LAS u32x2*)(lds + OFF_ST + (tv * 16 + fr) * SQ + (td * 16 + fq * 4) * 2) = (u32x2){cvt_pk_bf16(S[q][0], S[q][1]), cvt_pk_bf16(S[q][2], S[q][3])};
        }
    }
    asm volatile("s_waitcnt vmcnt(0)" ::: "memory");
    __syncthreads();
}
__device__ void phase_scan(const Params& p, LAS unsigned char* lds, int layer) {
    for (int item = blockIdx.x; item < 256; item += gridDim.x) {
        if (item < 128) { const int vhalf = item & 1, dir = (item >> 1) & 1, head = (item >> 2) & 3, bl = item >> 4; scan_item<128, 64, 0>(p, lds, layer, bl, head, dir, vhalf); }
        else if (item < 192) { const int i = item - 128, dir = i & 1, head = (i >> 1) & 3, bl = i >> 3; scan_item<64, 128, 1>(p, lds, layer, bl, head, dir, 0); }
        else { const int i = item - 192, dir = i & 1, head = (i >> 1) & 3, bl = i >> 3; scan_item<64, 128, 2>(p, lds, layer, bl, head, dir, 0); }
    }
}

__device__ void phase_ypass(const Params& p, int layer) {
    int tid_ = threadIdx.x; asm volatile("" : "+v"(tid_));
    const int lane = tid_ & 63, wid = tid_ >> 6;
    const int ch = (lane >> 4) * 128 + (lane & 15) * 8;
    f32x4 gn[3][2];
#pragma unroll
    for (int br = 0; br < 3; ++br) { const float* g = (br == 0 ? p.norm_a_g : br == 1 ? p.norm_b_g : p.norm_c_g) + layer * 512 + ch; gn[br][0] = *(const f32x4*)g; gn[br][1] = *(const f32x4*)(g + 4); }
    for (int rg = blockIdx.x; rg < MH / 16; rg += gridDim.x) {
        u32x4 a[2][3], b[2][3], gz[2][3];
#pragma unroll
        for (int t = 0; t < 2; ++t) { const int tok = rg * 16 + t * 8 + wid; const bf16_t* zr = p.z + (size_t)tok * NZ;
#pragma unroll
            for (int br = 0; br < 3; ++br) {
                a[t][br] = *(const u32x4*)(p.o + ((size_t)br * MH + tok) * 512 + ch);
                b[t][br] = *(const u32x4*)(p.o + ((size_t)(3 + br) * MH + tok) * 512 + ch);
                gz[t][br] = *(const u32x4*)(zr + (br == 0 ? ZA_G : br == 1 ? ZB_G : ZC_G) + ch); } }
#pragma unroll
        for (int t = 0; t < 2; ++t) { const int tok = rg * 16 + t * 8 + wid;
#pragma unroll
            for (int br = 0; br < 3; ++br) {
                float s[8], gt[8];
#pragma unroll
                for (int e = 0; e < 4; ++e) {
                    s[2 * e] = __uint_as_float(a[t][br][e] << 16) + __uint_as_float(b[t][br][e] << 16);
                    s[2 * e + 1] = __uint_as_float(a[t][br][e] & 0xffff0000u) + __uint_as_float(b[t][br][e] & 0xffff0000u);
                    gt[2 * e] = __uint_as_float(gz[t][br][e] << 16); gt[2 * e + 1] = __uint_as_float(gz[t][br][e] & 0xffff0000u); }
                float mu = 0.f;
                if (br == 1) {
#pragma unroll
                    for (int j = 0; j < 8; ++j) mu += s[j];
#pragma unroll
                    for (int m = 8; m >= 1; m >>= 1) mu += __shfl_xor(mu, m);
                    mu *= (1.0f / 128.0f);
                }
                float ss = 0.f;
#pragma unroll
                for (int j = 0; j < 8; ++j) { s[j] -= mu; ss += s[j] * s[j]; }
#pragma unroll
                for (int m = 8; m >= 1; m >>= 1) ss += __shfl_xor(ss, m);
                const float rstd = rsqrtf(ss * (1.0f / 128.0f) + 1e-6f);
                float r[8];
#pragma unroll
                for (int j = 0; j < 8; ++j) { const float gn_ = gn[br][j >> 2][j & 3]; const float sg = sigmoidf_(gt[j]);
                    const float act = br == 0 ? sg : gt[j] * sg; r[j] = s[j] * rstd * gn_ * act; }
                *(u32x4*)(p.o + ((size_t)br * MH + tok) * 512 + ch) = (u32x4){cvt_pk_bf16(r[0], r[1]), cvt_pk_bf16(r[2], r[3]), cvt_pk_bf16(r[4], r[5]), cvt_pk_bf16(r[6], r[7])};
            } }
    }
}

#define XB_TMO      128
#define XB_XCNT(j)  (256  + 64 * (j))
#define XB_XSUB(j)  (1280 + 64 * (j))
#define XB_XGEN(j)  (2304 + 64 * (j))
#define XB_TOP      3328
#define XB_TOPGEN   3392
#define XCD_BAR_WORDS 3456
#define XB_SPIN_CAP (1u << 22)
__device__ __forceinline__ unsigned xb_ld(unsigned* p)              { return __hip_atomic_load(p, __ATOMIC_RELAXED, __HIP_MEMORY_SCOPE_AGENT); }
__device__ __forceinline__ unsigned xb_add(unsigned* p, unsigned v) { return __hip_atomic_fetch_add(p, v, __ATOMIC_RELAXED, __HIP_MEMORY_SCOPE_AGENT); }
__device__ __forceinline__ unsigned xb_xcc_id() { return (unsigned)__builtin_amdgcn_s_getreg((3 << 11) | 20) & 0xFu; }
#define XB_SPIN(cond, bar) do { unsigned _sp = 0; while (cond) { __builtin_amdgcn_s_sleep(1); \
    if ((++_sp & 255u) == 0u) { if (xb_ld(&(bar)[XB_TMO])) break; if (_sp > XB_SPIN_CAP) { atomicAdd(&(bar)[XB_TMO], 1u); break; } } } } while (0)
struct XcdBarrier { unsigned* bar; unsigned x; volatile LAS unsigned* st; };
__device__ __forceinline__ XcdBarrier xcd_barrier_post(unsigned* bar, volatile LAS unsigned* st) {
    XcdBarrier b; b.bar = bar; b.x = xb_xcc_id(); b.st = st;
    if (threadIdx.x == 0) (void)xb_add(&bar[XB_XCNT(b.x)], 1u);
    return b;
}
__device__ __forceinline__ void xcd_barrier_complete(unsigned* bar, unsigned x, unsigned& nloc, unsigned& nx) {
    const unsigned G = gridDim.x * gridDim.y * gridDim.z;
    unsigned sum, cnt, mine, sp = 0u;
    for (;;) {
        sum = 0u; cnt = 0u; mine = 0u;
#pragma unroll
        for (unsigned j = 0; j < 16; ++j) { const unsigned c = xb_ld(&bar[XB_XCNT(j)]); sum += c; cnt += (c > 0u) ? 1u : 0u; mine = (j == x) ? c : mine; }
        if (sum == G) break;
        __builtin_amdgcn_s_sleep(1);
        if ((++sp & 255u) == 0u) { if (xb_ld(&bar[XB_TMO])) break; if (sp > XB_SPIN_CAP) { atomicAdd(&bar[XB_TMO], 1u); break; } }
    }
    nloc = mine > 0u ? mine : 1u; nx = cnt > 0u ? cnt : 1u;
}
__device__ __forceinline__ void xcd_barrier(const XcdBarrier& b) {
    asm volatile("s_waitcnt vmcnt(0)" ::: "memory");
    __syncthreads();
    if (threadIdx.x == 0) {
        unsigned* bar = b.bar;
        __builtin_amdgcn_s_waitcnt(0);
        unsigned nloc = b.st[0], nx = b.st[1];
        if (nloc == 0u) { xcd_barrier_complete(bar, b.x, nloc, nx); b.st[0] = nloc; b.st[1] = nx; }
        const unsigned old = xb_add(&bar[XB_XSUB(b.x)], 1u);
        const unsigned gen = old / nloc;
        if (old + 1u == (gen + 1u) * nloc) {
            __builtin_amdgcn_fence(__ATOMIC_RELEASE, "agent");
            asm volatile("s_waitcnt vmcnt(0)" ::: "memory");
            const unsigned og = xb_add(&bar[XB_TOP], 1u);
            const unsigned tg = og / nx;
            if (og + 1u == (tg + 1u) * nx) xb_add(&bar[XB_TOPGEN], 1u);
            else XB_SPIN(xb_ld(&bar[XB_TOPGEN]) == tg, bar);
            __builtin_amdgcn_fence(__ATOMIC_ACQUIRE, "agent");
            xb_add(&bar[XB_XGEN(b.x)], 1u);
            asm volatile("s_waitcnt vmcnt(0)" ::: "memory");
        } else {
            XB_SPIN(xb_ld(&bar[XB_XGEN(b.x)]) == gen, bar);
            __builtin_amdgcn_fence(__ATOMIC_ACQUIRE, "agent");
            asm volatile("s_waitcnt vmcnt(0)" ::: "memory");
        }
    }
    __syncthreads();
}

constexpr int N_PHASES = 1 + DEPTH * (1 + 1 + NGRP * 4 + 3) + 1;

__global__ void __launch_bounds__(512, 2) mega(Params p, int ph0, int ph1) {
    extern __shared__ __attribute__((aligned(16))) unsigned char shm[];
    LAS unsigned char* lds = (LAS unsigned char*)shm;
    cg::grid_group grid = cg::this_grid();
    volatile LAS unsigned* xst = (volatile LAS unsigned*)(lds + LDS_MAIN);
    if (threadIdx.x == 0) { xst[0] = 0u; xst[1] = 0u; }
    __syncthreads();
    const XcdBarrier xb = xcd_barrier_post(p.bar, xst);
    int pc = 0;
#define PHASE_BEGIN if (pc >= ph0 && pc < ph1) {
#define PHASE_END   if (pc + 1 < ph1) { if (ph1 < 0) grid.sync(); else xcd_barrier(xb); } } ++pc;
    PHASE_BEGIN
        phase_prologue(p, lds);
        phase_conv(p, lds, 0);
    PHASE_END
    for (int l = 0; l < DEPTH; ++l) {
        const float* modL = p.mod + (size_t)l * BATCH * (6 * D);
        const float* xinL = (l == 0 ? p.x : p.out);
        PHASE_BEGIN
            if (l > 0) phase_conv(p, lds, l);
            phase_norm(xinL, p.norm1_g + l * D, modL, 0, D, p.h, 2 * MH);
        PHASE_END
        for (int grp = 0; grp < NGRP; ++grp) {
            const float* modg = modL + (size_t)grp * GB * (6 * D);
            float* xg = p.out + (size_t)grp * MH * D;
            const float* xin0 = xinL + (size_t)grp * MH * D;
            bf16_t* hg = p.h + (size_t)grp * MH * D;
            if (grp == 0) {
            PHASE_BEGIN
                pg8::Gemm g{hg, p.wt_in, D, D, D}; pg8::ProjOrder S; S.base.init(MH, NZ, gridDim.x, blockIdx.x);
                pg8::EpiZ E{p.z, NZ}; pg8::gemm_phase(lds, g, S, E);
            PHASE_END
            }
            PHASE_BEGIN
                phase_scan(p, lds, l);
            PHASE_END
            PHASE_BEGIN
                phase_ypass(p, l);
            PHASE_END
            PHASE_BEGIN
                pg8::Gemm g{p.o, p.wt_p, 512, 512, 512}; pg8::MergeOrder S; S.base.init(MH, D, gridDim.x, blockIdx.x);
                pg8::EpiMerge E{p.z, hg}; pg8::gemm_phase(lds, g, S, E);
            PHASE_END
            PHASE_BEGIN
                { pg8::Gemm g{hg, p.wt_out, D, D, D}; pg8::StaticOrder S; S.init(MH, D, gridDim.x, blockIdx.x);
                  pg8::EpiRes E{xin0, xg, modg + 2 * D}; pg8::gemm_phase(lds, g, S, E); }
                if (grp == 0) {
                    pg8::Gemm g{p.h + (size_t)MH * D, p.wt_in, D, D, D}; pg8::ProjOrder S; S.base.init(MH, NZ, gridDim.x, blockIdx.x);
                    pg8::EpiZ E{p.z, NZ}; pg8::gemm_phase(lds, g, S, E);
                }
            PHASE_END
        }
        {
            const float* modl = p.mod + (size_t)l * BATCH * (6 * D);
            PHASE_BEGIN
                phase_norm(p.out, p.norm2_g + l * D, modl, 3 * D, 4 * D, p.h2, 2 * MH);
            PHASE_END
            PHASE_BEGIN
                pg8::Gemm g{p.h2, p.wt_fi, D, D, D}; pg8::StaticOrder S; S.init(2 * MH, 2 * DFF, gridDim.x, blockIdx.x);
                pg8::EpiAct E{p.z, DFF}; pg8::gemm_phase(lds, g, S, E);
            PHASE_END
            PHASE_BEGIN
                pg8::Gemm g{p.z, p.wt_fo, DFF, DFF, DFF}; pg8::StaticOrder S; S.init(2 * MH, D, gridDim.x, blockIdx.x);
                pg8::EpiRes E{p.out, p.out, modl + 5 * D}; pg8::gemm_phase(lds, g, S, E);
            PHASE_END
        }
    }
    PHASE_BEGIN
        phase_final(p);
    PHASE_END
}

extern "C" void kernel_launch(void* const* d_in, const int* in_sizes, int n_in, void* d_out, int out_size, void* d_ws, size_t ws_size, hipStream_t stream) {
    Params p{};
    const float** f = (const float**)&p;
    for (int i = 0; i < 20; ++i) f[i] = (const float*)d_in[i];
    p.out = (float*)d_out;
    char* w = (char*)d_ws; size_t off = 0;
    auto take = [&](size_t bytes) { char* r = w + off; off += (bytes + 255) & ~(size_t)255; return r; };
    p.wt_in = (bf16_t*)take((size_t)NZ * D * 2);
    p.wt_p = (bf16_t*)take((size_t)3 * D * 512 * 2);
    p.wt_out = (bf16_t*)take((size_t)D * D * 2);
    p.wt_fi = (bf16_t*)take((size_t)2 * DFF * D * 2);
    p.wt_fo = (bf16_t*)take((size_t)D * DFF * 2);
    p.mod = (float*)take((size_t)DEPTH * BATCH * 6 * D * 4);
    p.lb = (float*)take((size_t)DEPTH * 512 * 4);
    p.rope = (float2*)take((size_t)SEQ * 32 * 8);
    p.h = (bf16_t*)take((size_t)2 * MH * D * 2);
    p.h2 = p.h;
    p.z = (bf16_t*)take((size_t)MH * NZ * 2);
    p.o = (bf16_t*)take((size_t)2 * 3 * MH * 512 * 2);
    p.bar = (unsigned*)take((size_t)XCD_BAR_WORDS * 4);
    if (off > ws_size) { fprintf(stderr, "workspace too small: need %zu have %zu\n", off, ws_size); return; }
    static int grid_blocks = 0;
    if (!grid_blocks) {
        (void)hipFuncSetAttribute((const void*)mega, hipFuncAttributeMaxDynamicSharedMemorySize, LDS_BYTES);
        int dev = 0, cus = 0, per_cu = 0;
        (void)hipGetDevice(&dev);
        (void)hipDeviceGetAttribute(&cus, hipDeviceAttributeMultiprocessorCount, dev);
        (void)hipOccupancyMaxActiveBlocksPerMultiprocessor(&per_cu, mega, 512, LDS_BYTES);
        if (per_cu < 1) per_cu = 1;
        grid_blocks = cus * 1;
    }
    (void)hipMemsetAsync(p.bar, 0, (size_t)XCD_BAR_WORDS * 4, stream);
#if MULTI_LAUNCH
    for (int ph = 0; ph < N_PHASES; ++ph)
        hipLaunchKernelGGL(mega, dim3(grid_blocks), dim3(512), LDS_BYTES, stream, p, ph, ph + 1);
#else
    int ph0 = 0, ph1 = N_PHASES;
    void* args[] = {&p, &ph0, &ph1};
    hipError_t e = hipLaunchCooperativeKernel((void*)mega, dim3(grid_blocks), dim3(512), args, LDS_BYTES, stream);
    if (e != hipSuccess) fprintf(stderr, "cooperative launch failed: %s (grid %d)\n", hipGetErrorString(e), grid_blocks);
#endif
}
```

```cpp
#include <hip/hip_runtime.h>
#include <hip/hip_cooperative_groups.h>
#include <cstdio>
namespace cg = cooperative_groups;

#ifndef MULTI_LAUNCH
#define MULTI_LAUNCH 0
#endif

#define LAS __attribute__((address_space(3)))
typedef unsigned short bf16_t;
typedef short bf16x8 __attribute__((ext_vector_type(8)));
typedef float f32x4 __attribute__((ext_vector_type(4)));
typedef unsigned u32x4 __attribute__((ext_vector_type(4)));
typedef unsigned u32x2 __attribute__((ext_vector_type(2)));

constexpr int D = 1024, BATCH = 16, SEQ = 2048, DEPTH = 4;
constexpr int GB = 8;
constexpr int NGRP = BATCH / GB;
constexpr int MH = GB * SEQ;
constexpr int NIN = 8736, NZ = 9216, DFF = 2816;
constexpr int LDS_MAIN = 155648;
constexpr int LDS_BYTES = LDS_MAIN + 16;
constexpr int ZA_Q = 0, ZA_FF = 512, ZA_FB = 1024, ZA_I = 1536, ZA_G = 2048;
constexpr int ZB_Q = 2560, ZB_K = 2816, ZB_V = 3072, ZB_G = 3584;
constexpr int ZC_Q = 4096, ZC_K = 4352, ZC_V = 4608, ZC_G = 5120, ZC_LG = 8704;
constexpr int ZG_A = 5632;

struct Params {
    const float *x, *c, *norm1_g, *w_ada, *b_ada, *w_in, *lb_logits, *norm_a_g, *norm_b_g, *norm_c_g, *w_alpha, *b_alpha,
                *w_pa, *w_pb, *w_pc, *w_out, *norm2_g, *w_ffn_in, *w_ffn_out, *norm_f_g;
    float* out;
    bf16_t *wt_in;
    bf16_t *wt_p;
    bf16_t *wt_out;
    bf16_t *wt_fi;
    bf16_t *wt_fo;
    float *mod;
    float *lb;
    float2 *rope;
    bf16_t *h;
    bf16_t *h2;
    bf16_t *z;
    bf16_t *o;
    unsigned *bar;
};

__device__ __forceinline__ float bf2f(bf16_t h) { return __uint_as_float(((unsigned)h) << 16); }
__device__ __forceinline__ bf16_t f2bf(float f) { unsigned u = __float_as_uint(f); u += 0x7fffu + ((u >> 16) & 1u); return (bf16_t)(u >> 16); }
__device__ __forceinline__ unsigned pk2(float lo, float hi) { return (unsigned)f2bf(lo) | ((unsigned)f2bf(hi) << 16); }
typedef __bf16 bf16x2_t __attribute__((ext_vector_type(2)));
typedef float f32x2_t __attribute__((ext_vector_type(2)));
__device__ __forceinline__ unsigned cvt_pk_bf16(float lo, float hi) { const f32x2_t f = {lo, hi}; const bf16x2_t v = __builtin_convertvector(f, bf16x2_t); return __builtin_bit_cast(unsigned, v); }
__device__ __forceinline__ float sigmoidf_(float x) { return __builtin_amdgcn_rcpf(1.0f + __expf(-x)); }
__device__ __forceinline__ float clampf(float x, float lo, float hi) { return fminf(fmaxf(x, lo), hi); }

namespace pg8 {
constexpr int BM = 256, BK = 64, HALF = 128, HTB = HALF * BK * 2, STAGE_BYTES = 8 * HTB, NXCD = 8, WGM = 8;
__host__ __device__ __forceinline__ int lds_byte(int r, int c) { const int st = (r >> 4) * 2 + (c >> 5), rr = r & 15, cc = c & 31, ob = rr * 64 + cc * 2; return st * 1024 + (ob ^ (((ob >> 9) & 1) << 5)); }
__host__ __device__ __forceinline__ void stage_rc(int b, int& R, int& C) { const int st = b / 1024, sb = b % 1024, swz = sb ^ (((sb >> 9) & 1) << 5); R = (st >> 1) * 16 + swz / 64; C = (st & 1) * 32 + (swz % 64) / 2; }
__host__ __device__ __forceinline__ int perm32(int rho) { const int n = rho >> 4, i = rho & 15; return 8 * (i >> 2) + 4 * n + (i & 3); }

struct Unit { int pm, pn; };
struct Gemm { const bf16_t* A; const bf16_t* Bt; int lda, ldb, K; };

struct StaticOrder {
    int nM, nN, nwg, G, c;
    __device__ void init(int M, int N, int G_, int c_) { nM = M / BM; nN = N / BM; nwg = nM * nN; G = G_; c = c_; }
    __device__ bool next(int i, Unit& u) const {
        const long L = (long)i * G + c; if (L >= nwg) return false;
        int wgid = (int)L; { const int q = nwg / NXCD, r = nwg % NXCD, xcd = wgid % NXCD, off = wgid / NXCD; wgid = (xcd < r ? xcd * (q + 1) : r * (q + 1) + (xcd - r) * q) + off; }
        const int nig = WGM * nN, gid = wgid / nig, fm = gid * WGM, gsz = (nM - fm) < WGM ? (nM - fm) : WGM;
        u.pm = fm + ((wgid % nig) % gsz); u.pn = (wgid % nig) / gsz; return true;
    }
};
struct ProjOrder {
    StaticOrder base;
    __device__ bool next(int i, Unit& u) const { if (!base.next(i, u)) return false; u.pn = (u.pn + 22) % 36; return true; }
};
struct MergeOrder {
    StaticOrder base;
    __device__ bool next(int i, Unit& u) const { Unit t; if (!base.next(i / 3, t)) return false; const int br = i % 3; u.pm = br * (MH / BM) + t.pm; u.pn = br * (D / BM) + t.pn; return true; }
};

typedef f32x4 Acc[2][2][4][2];
__device__ __forceinline__ void zero_acc(Acc& acc) {
#pragma unroll
    for (int a = 0; a < 2; ++a)
#pragma unroll
        for (int b = 0; b < 2; ++b)
#pragma unroll
            for (int m = 0; m < 4; ++m)
#pragma unroll
                for (int n = 0; n < 2; ++n) acc[a][b][m][n] = (f32x4){0.f, 0.f, 0.f, 0.f};
}

struct EpiZ {
    static constexpr bool PERM = true;
    bf16_t* O; int ldc;
    __device__ __forceinline__ void operator()(Acc& acc, const Unit& u, int wr, int wc, int fr, int fq) const {
        const int row0 = u.pm * BM + wr * 64 + fr, col0 = u.pn * BM + wc * 32 + 8 * fq;
#pragma unroll
        for (int ai = 0; ai < 2; ++ai)
#pragma unroll
            for (int m = 0; m < 4; ++m) { bf16_t* rowp = O + (size_t)(row0 + ai * HALF + m * 16) * ldc + col0;
#pragma unroll
                for (int bj = 0; bj < 2; ++bj) { f32x4 v0 = acc[ai][bj][m][0], v1 = acc[ai][bj][m][1];
                    if (u.pn < 2) {
#pragma unroll
                        for (int j = 0; j < 4; ++j) { v0[j] *= sigmoidf_(v0[j]); v1[j] *= sigmoidf_(v1[j]); } }
                    else if ((u.pn >= 2 && u.pn < 6) || (u.pn >= 22 && u.pn < 34)) {
#pragma unroll
                        for (int j = 0; j < 4; ++j) { v0[j] = sigmoidf_(v0[j]); v1[j] = sigmoidf_(v1[j]); } }
                    u32x4 w; w.x = cvt_pk_bf16(v0[0], v0[1]); w.y = cvt_pk_bf16(v0[2], v0[3]); w.z = cvt_pk_bf16(v1[0], v1[1]); w.w = cvt_pk_bf16(v1[2], v1[3]);
                    *(u32x4*)(rowp + bj * HALF) = w; } }
        zero_acc(acc);
    }
};
struct EpiAct {
    static constexpr bool PERM = true;
    bf16_t* O; int ldc;
    __device__ __forceinline__ void operator()(Acc& acc, const Unit& u, int wr, int wc, int fr, int fq) const {
        const int row0 = u.pm * BM + wr * 64 + fr, col0 = u.pn * HALF + wc * 32 + 8 * fq;
#pragma unroll
        for (int ai = 0; ai < 2; ++ai)
#pragma unroll
            for (int m = 0; m < 4; ++m) { bf16_t* rowp = O + (size_t)(row0 + ai * HALF + m * 16) * ldc + col0;
                float r[8];
#pragma unroll
                for (int n = 0; n < 2; ++n)
#pragma unroll
                    for (int j = 0; j < 4; ++j) { const float g = acc[ai][0][m][n][j], up = acc[ai][1][m][n][j]; r[n * 4 + j] = g * sigmoidf_(g) * up; }
                u32x4 w; w.x = cvt_pk_bf16(r[0], r[1]); w.y = cvt_pk_bf16(r[2], r[3]); w.z = cvt_pk_bf16(r[4], r[5]); w.w = cvt_pk_bf16(r[6], r[7]);
                *(u32x4*)rowp = w; }
        zero_acc(acc);
    }
};
struct EpiRes {
    static constexpr bool PERM = true;
    const float* xin; float* xout; const float* gm;
    __device__ __forceinline__ void operator()(Acc& acc, const Unit& u, int wr, int wc, int fr, int fq) const {
        const int row0 = u.pm * BM + wr * 64 + fr, col0 = u.pn * BM + wc * 32 + 8 * fq;
        const float* gb = gm + (size_t)((u.pm * BM) / SEQ) * (6 * D);
        f32x4 gv[2][2];
#pragma unroll
        for (int bj = 0; bj < 2; ++bj)
#pragma unroll
            for (int n = 0; n < 2; ++n) gv[bj][n] = *(const f32x4*)(gb + col0 + bj * HALF + n * 4);
#pragma unroll
        for (int ai = 0; ai < 2; ++ai) {
            f32x4 xi[4][2][2];
#pragma unroll
            for (int m = 0; m < 4; ++m) { const size_t off = (size_t)(row0 + ai * HALF + m * 16) * D + col0;
#pragma unroll
                for (int bj = 0; bj < 2; ++bj)
#pragma unroll
                    for (int n = 0; n < 2; ++n) xi[m][bj][n] = *(const f32x4*)(xin + off + bj * HALF + n * 4); }
#pragma unroll
            for (int m = 0; m < 4; ++m) { const size_t off = (size_t)(row0 + ai * HALF + m * 16) * D + col0;
#pragma unroll
                for (int bj = 0; bj < 2; ++bj)
#pragma unroll
                    for (int n = 0; n < 2; ++n) *(f32x4*)(xout + off + bj * HALF + n * 4) = xi[m][bj][n] + gv[bj][n] * acc[ai][bj][m][n]; }
        }
        zero_acc(acc);
    }
};
struct EpiMerge {
    static constexpr bool PERM = true;
    const bf16_t* z; bf16_t* O;
    __device__ __forceinline__ void operator()(Acc& acc, const Unit& u, int wr, int wc, int fr, int fq) const {
        const int br = u.pm / (MH / BM), pm = u.pm - br * (MH / BM), pn = u.pn - br * (D / BM);
        const int row0 = pm * BM + wr * 64 + fr, col0 = pn * BM + wc * 32 + 8 * fq;
        const bf16_t* zg = z + ZG_A + br * D + col0;
#pragma unroll
        for (int ai = 0; ai < 2; ++ai) {
            u32x4 g0[4][2], g1[4][2];
#pragma unroll
            for (int m = 0; m < 4; ++m) { const size_t row = (size_t)(row0 + ai * HALF + m * 16);
#pragma unroll
                for (int bj = 0; bj < 2; ++bj) { g0[m][bj] = *(const u32x4*)(zg + row * NZ + bj * HALF);
                    if (br < 2) g1[m][bj] = *(const u32x4*)(zg + row * NZ + D + bj * HALF); } }
#pragma unroll
            for (int m = 0; m < 4; ++m) { const size_t row = (size_t)(row0 + ai * HALF + m * 16);
#pragma unroll
                for (int bj = 0; bj < 2; ++bj) {
                    float s[8];
                    if (br < 2) {
#pragma unroll
                        for (int e = 0; e < 4; ++e) {
                            const float a0 = __uint_as_float(g0[m][bj][e] << 16), a1 = __uint_as_float(g0[m][bj][e] & 0xffff0000u);
                            const float b0 = __uint_as_float(g1[m][bj][e] << 16), b1 = __uint_as_float(g1[m][bj][e] & 0xffff0000u);
                            s[2 * e] = a0 * __builtin_amdgcn_rcpf(fmaxf(b0, 1e-30f)); s[2 * e + 1] = a1 * __builtin_amdgcn_rcpf(fmaxf(b1, 1e-30f)); }
#pragma unroll
                        for (int n = 0; n < 2; ++n)
#pragma unroll
                            for (int j = 0; j < 4; ++j) acc[ai][bj][m][n][j] *= s[n * 4 + j];
                    } else {
#pragma unroll
                        for (int e = 0; e < 4; ++e) { s[2 * e] = __uint_as_float(g0[m][bj][e] << 16); s[2 * e + 1] = __uint_as_float(g0[m][bj][e] & 0xffff0000u); }
                        const f32x4 v0 = acc[ai][bj][m][0], v1 = acc[ai][bj][m][1];
                        u32x4 w; w.x = cvt_pk_bf16(v0[0] * s[0], v0[1] * s[1]); w.y = cvt_pk_bf16(v0[2] * s[2], v0[3] * s[3]);
                        w.z = cvt_pk_bf16(v1[0] * s[4], v1[1] * s[5]); w.w = cvt_pk_bf16(v1[2] * s[6], v1[3] * s[7]);
                        *(u32x4*)(O + row * D + col0 + bj * HALF) = w;
                        acc[ai][bj][m][0] = (f32x4){0.f, 0.f, 0.f, 0.f}; acc[ai][bj][m][1] = (f32x4){0.f, 0.f, 0.f, 0.f};
                    } } }
        }
    }
};

template <class Epi, class Sched>
__device__ __forceinline__ void gemm_phase(LAS unsigned char* lds, const Gemm g, const Sched& S, const Epi& E) {
    int tid_ = threadIdx.x; asm volatile("" : "+v"(tid_));
    const int tid = tid_, wid = __builtin_amdgcn_readfirstlane(tid >> 6), lane = tid & 63, wr = wid >> 2, wc = wid & 3, fr = lane & 15, fq = lane >> 4;
    const int K = g.K, nt = K / BK;
    unsigned voffA[2], voffB[2];
#pragma unroll
    for (int i = 0; i < 2; ++i) { int R, C; stage_rc(tid * 16 + i * 8192, R, C); const int Rb = Epi::PERM ? ((R & ~31) + perm32(R & 31)) : R;
        voffA[i] = (unsigned)(R * g.lda + C) * 2u; voffB[i] = (unsigned)(Rb * g.ldb + C) * 2u; }
    const size_t kstep = (size_t)(BK * 2);
    const size_t hstepA = (size_t)HALF * g.lda * 2, hstepB = (size_t)HALF * g.ldb * 2;
    const size_t tstepA = 2 * hstepA, tstepB = 2 * hstepB;
    const unsigned ldsw = (unsigned)wid * 1024u;
    const int aoff = lds_byte(wr * 64 + fr, fq * 8), boff = lds_byte(wc * 32 + fr, fq * 8);
#define PG8_SA(b, h) (((b) * 2 + (h)) * HTB)
#define PG8_SB(b, h) ((4 + (b) * 2 + (h)) * HTB)
#define PG8_STAGE(bufoff, gbase, voff) do { _Pragma("unroll") for (int _i = 0; _i < 2; ++_i) \
        __builtin_amdgcn_global_load_lds((const unsigned*)((const char*)(gbase) + (voff)[_i]), (LAS unsigned*)(lds + (bufoff) + ldsw + _i * 8192), 16, 0, 0); } while (0)
#define PG8_LDA(dst, b, h) do { _Pragma("unroll") for (int m = 0; m < 4; ++m) _Pragma("unroll") for (int k = 0; k < 2; ++k) dst[m][k] = *(const LAS bf16x8*)(lds + PG8_SA(b, h) + aoff + m * 2048 + k * 1024); } while (0)
#define PG8_LDB(dst, b, h) do { _Pragma("unroll") for (int n = 0; n < 2; ++n) _Pragma("unroll") for (int k = 0; k < 2; ++k) dst[n][k] = *(const LAS bf16x8*)(lds + PG8_SB(b, h) + boff + n * 2048 + k * 1024); } while (0)
#define PG8_MMA(ai, bj, At, Bt) do { __builtin_amdgcn_s_setprio(1); _Pragma("unroll") for (int m = 0; m < 4; ++m) _Pragma("unroll") for (int n = 0; n < 2; ++n) _Pragma("unroll") for (int k = 0; k < 2; ++k) \
        acc[ai][bj][m][n] = __builtin_amdgcn_mfma_f32_16x16x32_bf16(Bt[n][k], At[m][k], acc[ai][bj][m][n], 0, 0, 0); __builtin_amdgcn_s_setprio(0); } while (0)
#define PG8_WAIT_V(n) asm volatile("s_waitcnt vmcnt(" #n ")" ::: "memory")
#define PG8_WAIT_L(n) asm volatile("s_waitcnt lgkmcnt(" #n ")" ::: "memory")
#define PG8_BAR __builtin_amdgcn_s_barrier()
#define PG8_SCHED __builtin_amdgcn_sched_barrier(0)
    Unit cur, nxt; int ui = 0;
    if (!S.next(0, cur)) return;
    Acc acc; zero_acc(acc);
    bf16x8 At[4][2], B0[2][2], B1[2][2];
    const char* cA = (const char*)g.A + (size_t)cur.pm * tstepA; const char* cB = (const char*)g.Bt + (size_t)cur.pn * tstepB;
    PG8_STAGE(PG8_SB(0, 0), cB, voffB); PG8_STAGE(PG8_SA(0, 0), cA, voffA); PG8_STAGE(PG8_SB(0, 1), cB + hstepB, voffB); PG8_STAGE(PG8_SA(0, 1), cA + hstepA, voffA);
    if (wr == 1) PG8_BAR;
    PG8_WAIT_V(4); PG8_BAR;
    PG8_STAGE(PG8_SB(1, 0), cB + kstep, voffB); PG8_STAGE(PG8_SA(1, 0), cA + kstep, voffA); PG8_STAGE(PG8_SB(1, 1), cB + hstepB + kstep, voffB);
    PG8_WAIT_V(6); PG8_BAR;
    for (;;) {
        const bool has_next = S.next(ui + 1, nxt);
        const char* nA = has_next ? (const char*)g.A + (size_t)nxt.pm * tstepA : cA; const char* nB = has_next ? (const char*)g.Bt + (size_t)nxt.pn * tstepB : cB;
        for (int t = 0; t < nt; t += 2) {
            const bool last = (t == nt - 2);
            const char* a1 = cA + (size_t)(t + 1) * kstep;
            const char* a2 = last ? nA : cA + (size_t)(t + 2) * kstep; const char* b2 = last ? nB : cB + (size_t)(t + 2) * kstep;
            const char* a3 = a2 + kstep; const char* b3 = b2 + kstep;
            PG8_LDB(B0, 0, 0); PG8_SCHED; PG8_LDA(At, 0, 0); PG8_STAGE(PG8_SA(1, 1), a1 + hstepA, voffA);
            PG8_WAIT_L(8); PG8_BAR; PG8_WAIT_L(0); PG8_MMA(0, 0, At, B0); PG8_BAR; PG8_SCHED;
            PG8_LDB(B1, 0, 1); PG8_STAGE(PG8_SB(0, 0), b2, voffB);
            PG8_BAR; PG8_WAIT_L(0); PG8_MMA(0, 1, At, B1); PG8_BAR;
            PG8_LDA(At, 0, 1); PG8_STAGE(PG8_SA(0, 0), a2, voffA);
            PG8_BAR; PG8_WAIT_L(0); PG8_MMA(1, 0, At, B0); PG8_BAR; PG8_SCHED;
            PG8_STAGE(PG8_SB(0, 1), b2 + hstepB, voffB);
            PG8_WAIT_V(6); PG8_BAR; PG8_MMA(1, 1, At, B1); PG8_BAR;
            PG8_LDB(B0, 1, 0); PG8_SCHED; PG8_LDA(At, 1, 0); PG8_STAGE(PG8_SA(0, 1), a2 + hstepA, voffA);
            PG8_WAIT_L(8); PG8_BAR; PG8_WAIT_L(0); PG8_MMA(0, 0, At, B0); PG8_BAR; PG8_SCHED;
            PG8_LDB(B1, 1, 1); PG8_STAGE(PG8_SB(1, 0), b3, voffB);
            PG8_BAR; PG8_WAIT_L(0); PG8_MMA(0, 1, At, B1); PG8_BAR;
            PG8_LDA(At, 1, 1); PG8_STAGE(PG8_SA(1, 0), a3, voffA);
            PG8_BAR; PG8_WAIT_L(0); PG8_MMA(1, 0, At, B0); PG8_BAR; PG8_SCHED;
            PG8_STAGE(PG8_SB(1, 1), b3 + hstepB, voffB);
            PG8_WAIT_V(6); PG8_BAR; PG8_MMA(1, 1, At, B1); PG8_BAR;
        }
        E(acc, cur, wr, wc, fr, fq);
        if (!has_next) break;
        cur = nxt; cA = nA; cB = nB; ++ui;
    }
    PG8_WAIT_V(0);
    if (wr == 0) PG8_BAR;
    PG8_BAR;
#undef PG8_SA
#undef PG8_SB
#undef PG8_STAGE
#undef PG8_LDA
#undef PG8_LDB
#undef PG8_MMA
#undef PG8_WAIT_V
#undef PG8_WAIT_L
#undef PG8_BAR
#undef PG8_SCHED
}
}

__device__ void phase_prologue(const Params& p, LAS unsigned char* lds) {
    int tid_ = threadIdx.x; asm volatile("" : "+v"(tid_)); const int tid = tid_;
    for (int i = blockIdx.x * 512 + tid; i < SEQ * 32; i += gridDim.x * 512) {
        const int pos = i >> 5, fi = i & 31;
        const float invf = exp2f(-(float)fi * (13.287712379549449f / 32.0f));
        const float ang = (float)pos * invf;
        double rev = (double)ang * 0.15915494309189535;
        rev -= rint(rev);
        const float rf = (float)rev;
        p.rope[i] = make_float2(__builtin_amdgcn_cosf(rf), __builtin_amdgcn_sinf(rf));
    }
    if (blockIdx.x == 0) {
        const int i = tid;
        float lg[DEPTH], mx = -1e30f;
#pragma unroll
        for (int l = 0; l < DEPTH; ++l) { lg[l] = p.lb_logits[l * 512 + i]; mx = fmaxf(mx, lg[l]); }
        float s = 0.f;
#pragma unroll
        for (int l = 0; l < DEPTH; ++l) { lg[l] = expf(lg[l] - mx); s += lg[l]; }
        const float inv = 1.0f / s; const float p0 = lg[0] * inv; float cum = 0.f;
#pragma unroll
        for (int l = 0; l < DEPTH; ++l) { cum += lg[l] * inv; p.lb[l * 512 + i] = fmaxf(cum - p0, 0.0f); }
    }
    LAS float* cact = (LAS float*)lds;
    LAS float* red = (LAS float*)(lds + 65536);
    for (int item = blockIdx.x; item < DEPTH * 48; item += gridDim.x) {
        const int l = item / 48, cb = item % 48;
        for (int i = tid; i < BATCH * D; i += 512) { const float c = p.c[i]; cact[i] = c * sigmoidf_(c); }
        __syncthreads();
        const int col = tid & 127, kq = tid >> 7;
        float acc[16];
#pragma unroll
        for (int b = 0; b < 16; ++b) acc[b] = 0.f;
        const float* wp = p.w_ada + ((size_t)l * D + kq * 256) * (6 * D) + cb * 128 + col;
        for (int k = 0; k < 256; k += 4) {
            const float w0 = wp[(size_t)k * (6 * D)], w1 = wp[(size_t)(k + 1) * (6 * D)], w2 = wp[(size_t)(k + 2) * (6 * D)], w3 = wp[(size_t)(k + 3) * (6 * D)];
#pragma unroll
            for (int b = 0; b < 16; ++b) { const f32x4 cv = *(const LAS f32x4*)(cact + b * D + kq * 256 + k); acc[b] += cv[0] * w0 + cv[1] * w1 + cv[2] * w2 + cv[3] * w3; }
        }
#pragma unroll
        for (int b = 0; b < 16; ++b) red[(kq * 16 + b) * 128 + col] = acc[b];
        __syncthreads();
        for (int e = tid; e < 16 * 128; e += 512) {
            const int b = e >> 7, cc = e & 127;
            const float s = red[(0 * 16 + b) * 128 + cc] + red[(1 * 16 + b) * 128 + cc] + red[(2 * 16 + b) * 128 + cc] + red[(3 * 16 + b) * 128 + cc];
            p.mod[((size_t)l * BATCH + b) * (6 * D) + cb * 128 + cc] = s + p.b_ada[l * 6 * D + cb * 128 + cc];
        }
        __syncthreads();
    }
}

struct ConvTile { const float* src; int ldsrc; bf16_t* dst; int K; int k0; int n0; int kind; const float* wa; };
__device__ __forceinline__ int conv_srccol(int kind, int n) {
    if (kind == 1) return n < 5632 ? n : n < 8704 ? n + 32 : -2;
    if (kind == 2) { const int pn = n >> 8, bj = (n >> 7) & 1, ii = n & 127; return bj * DFF + pn * 128 + ii; }
    return n;
}
__device__ __forceinline__ ConvTile conv_decode(const Params& p, int l, int t) {
    constexpr int T_IN = 16 * 144, T_P = 3 * 8 * 16, T_OUT = 16 * 16, T_FI = 16 * 88;
    int i = t; ConvTile c;
    if (i < T_IN) { c = ConvTile{p.w_in + (size_t)l * D * NIN, NIN, p.wt_in, D, (i & 15) * 64, (i >> 4) * 64, 1, p.w_alpha + (size_t)l * 2 * 16 * 256}; return c; }
    i -= T_IN;
    if (i < T_P) { const int br = i / 128, r = i % 128;
        c = ConvTile{(br == 0 ? p.w_pa : br == 1 ? p.w_pb : p.w_pc) + (size_t)l * 512 * D, D, p.wt_p + (size_t)br * D * 512, 512, (r & 7) * 64, (r >> 3) * 64, 0, nullptr}; return c; }
    i -= T_P;
    if (i < T_OUT) { c = ConvTile{p.w_out + (size_t)l * D * D, D, p.wt_out, D, (i & 15) * 64, (i >> 4) * 64, 0, nullptr}; return c; }
    i -= T_OUT;
    if (i < T_FI) { c = ConvTile{p.w_ffn_in + (size_t)l * D * 2 * DFF, 2 * DFF, p.wt_fi, D, (i & 15) * 64, (i >> 4) * 64, 2, nullptr}; return c; }
    i -= T_FI;
    c = ConvTile{p.w_ffn_out + (size_t)l * DFF * D, D, p.wt_fo, DFF, (i % 44) * 64, (i / 44) * 64, 0, nullptr}; return c;
}
__device__ __forceinline__ void conv_load(const ConvTile& c, int tid, float (&v)[8]) {
    const int cidx = tid & 63;
    if (c.kind == 1 && c.n0 >= 8704) {
        const int fc = c.n0 + cidx - 8704, dr = fc >> 8, ch = fc & 255;
        float wa[16];
#pragma unroll
        for (int r = 0; r < 16; ++r) wa[r] = c.wa[(dr * 16 + r) * 256 + ch];
#pragma unroll
        for (int i = 0; i < 8; ++i) { const int r_ = (tid >> 6) + 8 * i; const float* sp = c.src + (size_t)(c.k0 + r_) * c.ldsrc + 5632 + dr * 16;
            float a = 0.f;
#pragma unroll
            for (int q = 0; q < 4; ++q) { const f32x4 t = *(const f32x4*)(sp + q * 4); a += t[0] * wa[q * 4] + t[1] * wa[q * 4 + 1] + t[2] * wa[q * 4 + 2] + t[3] * wa[q * 4 + 3]; }
            v[i] = a; }
        return;
    }
    const int col4 = (tid & 15) * 4; const int sc4 = conv_srccol(c.kind, c.n0 + col4);
#pragma unroll
    for (int i = 0; i < 2; ++i) { const int r = (tid >> 4) + 32 * i; const f32x4 t = *(const f32x4*)(c.src + (size_t)(c.k0 + r) * c.ldsrc + sc4);
        v[i * 4] = t[0]; v[i * 4 + 1] = t[1]; v[i * 4 + 2] = t[2]; v[i * 4 + 3] = t[3]; }
}
__device__ __forceinline__ void conv_to_lds(const ConvTile& c, int tid, LAS float* tile, const float (&v)[8]) {
    if (c.kind == 1 && c.n0 >= 8704) {
#pragma unroll
        for (int i = 0; i < 8; ++i) tile[((tid >> 6) + 8 * i) * 65 + (tid & 63)] = v[i];
    } else {
#pragma unroll
        for (int i = 0; i < 2; ++i)
#pragma unroll
            for (int j = 0; j < 4; ++j) tile[((tid >> 4) + 32 * i) * 65 + (tid & 15) * 4 + j] = v[i * 4 + j];
    }
}
__device__ void phase_conv(const Params& p, LAS unsigned char* lds, int l) {
    LAS float* tile = (LAS float*)lds;
    constexpr int TOT = 16 * 144 + 3 * 8 * 16 + 16 * 16 + 16 * 88 + 44 * 16;
    int tid_ = threadIdx.x; asm volatile("" : "+v"(tid_)); const int tid = tid_;
    int t = blockIdx.x;
    if (t >= TOT) return;
    ConvTile cur = conv_decode(p, l, t);
    float v[8]; conv_load(cur, tid, v);
    for (;;) {
        const int tn = t + gridDim.x; const bool has_next = tn < TOT;
        conv_to_lds(cur, tid, tile, v);
        ConvTile nxt = cur;
        if (has_next) { nxt = conv_decode(p, l, tn); conv_load(nxt, tid, v); }
        __syncthreads();
        {
            const int n = tid >> 3, kk = (tid & 7) * 8;
            float w[8];
#pragma unroll
            for (int j = 0; j < 8; ++j) w[j] = tile[(kk + j) * 65 + n];
            *(u32x4*)(cur.dst + (size_t)(cur.n0 + n) * cur.K + cur.k0 + kk) = (u32x4){cvt_pk_bf16(w[0], w[1]), cvt_pk_bf16(w[2], w[3]), cvt_pk_bf16(w[4], w[5]), cvt_pk_bf16(w[6], w[7])};
        }
        __syncthreads();
        if (!has_next) break;
        cur = nxt; t = tn;
    }
}

__device__ void phase_norm(const float* xg  , const float* gain, const float* modg  , int shoff, int scoff, bf16_t* h, int nrows) {
    int tid_ = threadIdx.x; asm volatile("" : "+v"(tid_));
    const int lane = tid_ & 63, wid = tid_ >> 6;
    f32x4 g[4];
#pragma unroll
    for (int i = 0; i < 4; ++i) g[i] = *(const f32x4*)(gain + lane * 4 + i * 256);
    for (int rg = blockIdx.x; rg < nrows / 16; rg += gridDim.x) {
        f32x4 v[2][4], sc[4], sh[4]; float ss[2] = {0.f, 0.f};
        const float* mb = modg + (size_t)((rg * 16) / SEQ) * (6 * D);
#pragma unroll
        for (int t = 0; t < 2; ++t) { const float* xr = xg + (size_t)(rg * 16 + t * 8 + wid) * D;
#pragma unroll
            for (int i = 0; i < 4; ++i) v[t][i] = *(const f32x4*)(xr + lane * 4 + i * 256); }
#pragma unroll
        for (int i = 0; i < 4; ++i) { sc[i] = *(const f32x4*)(mb + scoff + lane * 4 + i * 256); sh[i] = *(const f32x4*)(mb + shoff + lane * 4 + i * 256); }
#pragma unroll
        for (int t = 0; t < 2; ++t) {
#pragma unroll
            for (int i = 0; i < 4; ++i) ss[t] += v[t][i][0] * v[t][i][0] + v[t][i][1] * v[t][i][1] + v[t][i][2] * v[t][i][2] + v[t][i][3] * v[t][i][3];
#pragma unroll
            for (int m = 32; m >= 1; m >>= 1) ss[t] += __shfl_xor(ss[t], m); }
#pragma unroll
        for (int t = 0; t < 2; ++t) {
            const int row = rg * 16 + t * 8 + wid;
            const float rstd = rsqrtf(ss[t] * (1.0f / D) + 1e-6f);
#pragma unroll
            for (int i = 0; i < 4; ++i) { const int c = lane * 4 + i * 256;
                const f32x4 r = v[t][i] * rstd * g[i] * (sc[i] + 1.0f) + sh[i];
                *(u32x2*)(h + (size_t)row * D + c) = (u32x2){cvt_pk_bf16(r[0], r[1]), cvt_pk_bf16(r[2], r[3])}; }
        }
    }
}
__device__ void phase_final(const Params& p) {
    int tid_ = threadIdx.x; asm volatile("" : "+v"(tid_));
    const int lane = tid_ & 63, wid = tid_ >> 6;
    f32x4 g[4];
#pragma unroll
    for (int i = 0; i < 4; ++i) g[i] = *(const f32x4*)(p.norm_f_g + lane * 4 + i * 256);
    for (int rg = blockIdx.x; rg < BATCH * SEQ / 16; rg += gridDim.x) {
        f32x4 v[2][4]; float ss[2];
#pragma unroll
        for (int t = 0; t < 2; ++t) { const float* xr = p.out + (size_t)(rg * 16 + t * 8 + wid) * D;
#pragma unroll
            for (int i = 0; i < 4; ++i) v[t][i] = *(const f32x4*)(xr + lane * 4 + i * 256); }
#pragma unroll
        for (int t = 0; t < 2; ++t) { ss[t] = 0.f;
#pragma unroll
            for (int i = 0; i < 4; ++i) ss[t] += v[t][i][0] * v[t][i][0] + v[t][i][1] * v[t][i][1] + v[t][i][2] * v[t][i][2] + v[t][i][3] * v[t][i][3];
#pragma unroll
            for (int m = 32; m >= 1; m >>= 1) ss[t] += __shfl_xor(ss[t], m); }
#pragma unroll
        for (int t = 0; t < 2; ++t) { float* xr = p.out + (size_t)(rg * 16 + t * 8 + wid) * D;
            const float rstd = rsqrtf(ss[t] * (1.0f / D) + 1e-6f);
#pragma unroll
            for (int i = 0; i < 4; ++i) *(f32x4*)(xr + lane * 4 + i * 256) = v[t][i] * rstd * g[i]; }
    }
}

template <int DK, int DV, int MIX>
__device__ void scan_item(const Params& p, LAS unsigned char* lds, int layer, int bl, int head, int dir, int vhalf) {
    constexpr int TG = 512 / DK, TPG = 64 / TG;
    constexpr int TGV = 512 / DV, TPGV = 64 / TGV;
    constexpr int SQ = DK * 2 + 16, S64 = 144;
    constexpr int OFF_QT = 0, OFF_KT = OFF_QT + 64 * SQ, OFF_QS = OFF_KT + 64 * SQ, OFF_KL = OFF_QS + 64 * SQ, OFF_VT = OFF_KL + DK * S64,
                  OFF_P = OFF_VT + DV * S64, OFF_ST = OFF_P + 64 * S64, OFF_TOT = OFF_ST + DV * SQ, OFF_EL = OFF_TOT + TG * DK * 4,
                  OFF_RQ = OFF_EL + DK * 4, OFF_RK = OFF_RQ + 64 * DK * 2, OFF_RV = OFF_RK + 64 * DK * 2, OFF_RL = OFF_RV + 64 * DV * 2, OFF_END = OFF_RL + (MIX == 2 ? 64 * 128 : 0);
    static_assert(OFF_END <= LDS_MAIN, "lds");
    static_assert(OFF_RQ % 1024 == 0 || true, "");
    constexpr int NV = DV / 32;
    int tid_ = threadIdx.x; asm volatile("" : "+v"(tid_));
    const int tid = tid_, lane = tid & 63, wid = __builtin_amdgcn_readfirstlane(tid >> 6), fr = lane & 15, fq = lane >> 4;
    const int d = tid % DK, g = tid / DK, vv = tid % DV, gv = tid / DV;
    const bf16_t* zb = p.z + (size_t)(bl * SEQ) * NZ;
    int cbq, cbk, cbv;
    if (MIX == 0) { cbq = ZA_Q + head * 128; cbk = (dir ? ZA_FB : ZA_FF) + head * 128; cbv = ZA_I + head * 128 + vhalf * 64; }
    else if (MIX == 1) { cbq = ZB_Q + head * 64; cbk = ZB_K + head * 64; cbv = ZB_V + head * 128; }
    else { cbq = ZC_Q + head * 64; cbk = ZC_K + head * 64; cbv = ZC_V + head * 128; }
    float lbv = 0.f, oml = 1.f, gam = 1.f, bal = 0.f;
    if (MIX == 0) { lbv = p.lb[layer * 512 + head * 128 + d]; oml = 1.0f - lbv; }
    if (MIX == 1) { const int hh = dir ? 3 - head : head; gam = 1.0f - exp2f(-5.0f - (float)hh); }
    if (MIX == 2) bal = p.b_alpha[((size_t)layer * 2 + dir) * 256 + head * 64 + d];
    const int cbl = ZC_LG + dir * 256 + head * 64;
    float2 cbn = make_float2(1.f, 0.f);
    if (MIX == 1) cbn = p.rope[((dir ? 31 : 0) * 64) * 32 + (d & 31)];
    float2 rin[TPG];
    if (MIX == 1) {
#pragma unroll
        for (int tt = 0; tt < TPG; ++tt) { const int ip = g * TPG + tt; rin[tt] = p.rope[(dir ? 63 - ip : ip) * 32 + (d & 31)]; }
    }
    f32x4 S[4];
#pragma unroll
    for (int q = 0; q < 4; ++q) S[q] = (f32x4){0.f, 0.f, 0.f, 0.f};
    for (int i = tid * 16; i < DV * SQ; i += 512 * 16) *(LAS u32x4*)(lds + OFF_ST + i) = (u32x4){0u, 0u, 0u, 0u};
    const int ti = wid & 3;
    const int tj0 = (wid >> 2) * 2;
    const int tv0 = (wid >> 2) * NV;

    auto stage_rows = [&](int cn, int ldsoff, int colbase, int rbshift  ) {
        const int n = dir ? 31 - cn : cn;
        const bf16_t* zc = zb + (size_t)(n * 64) * NZ + colbase;
        const int rpw = 1024 >> rbshift, nwl = 64 / rpw, l16 = (1 << rbshift) >> 4;
        for (int wl = wid; wl < nwl; wl += 8) {
            const int row = wl * rpw + lane / l16, c16 = lane % l16; const int tk = dir ? 63 - row : row;
            __builtin_amdgcn_global_load_lds((const unsigned*)(zc + (size_t)tk * NZ + c16 * 8), (LAS unsigned*)(lds + ldsoff + wl * 1024), 16, 0, 0);
        }
    };
    constexpr int RBQ = (DK == 128) ? 8 : 7, RBV = (DV == 128) ? 8 : 7;
    stage_rows(0, OFF_RQ, cbq, RBQ); stage_rows(0, OFF_RK, cbk, RBQ); stage_rows(0, OFF_RV, cbv, RBV);
    if (MIX == 2) stage_rows(0, OFF_RL, cbl, 7);
    asm volatile("s_waitcnt vmcnt(0)" ::: "memory");
    __syncthreads();

    for (int cn = 0; cn < 32; ++cn) {
        const int n = dir ? 31 - cn : cn;
        float qv[TPG], kv[TPG], pl[TPG], sl[TPG];
        {
            float f[TPG];
            float2 rcs[TPG];
            if (MIX == 1) {
                const float2 cb = cbn;
                if (cn + 1 < 32) cbn = p.rope[((dir ? 30 - cn : cn + 1) * 64) * 32 + (d & 31)];
#pragma unroll
                for (int tt = 0; tt < TPG; ++tt) rcs[tt] = make_float2(cb.x * rin[tt].x - cb.y * rin[tt].y, cb.y * rin[tt].x + cb.x * rin[tt].y);
            }
#pragma unroll
            for (int tt = 0; tt < TPG; ++tt) {
                const int ip = g * TPG + tt;
                if (MIX == 0) {
                    qv[tt] = bf2f(*(const LAS bf16_t*)(lds + OFF_RQ + ip * (DK * 2) + d * 2));
                    const float sg = bf2f(*(const LAS bf16_t*)(lds + OFF_RK + ip * (DK * 2) + d * 2));
                    f[tt] = fmaxf(lbv + oml * sg, 1e-30f); kv[tt] = oml * (1.0f - sg);
                } else if (MIX == 1) {
                    const int dl = d & 31;
                    const float q1 = bf2f(*(const LAS bf16_t*)(lds + OFF_RQ + ip * (DK * 2) + dl * 2)), q2 = bf2f(*(const LAS bf16_t*)(lds + OFF_RQ + ip * (DK * 2) + dl * 2 + 64));
                    const float k1 = bf2f(*(const LAS bf16_t*)(lds + OFF_RK + ip * (DK * 2) + dl * 2)), k2 = bf2f(*(const LAS bf16_t*)(lds + OFF_RK + ip * (DK * 2) + dl * 2 + 64));
                    const float2 cs = rcs[tt];
                    if (d < 32) { qv[tt] = q1 * cs.x - q2 * cs.y; kv[tt] = (k1 * cs.x - k2 * cs.y) * 0.125f; }
                    else        { qv[tt] = q1 * cs.y + q2 * cs.x; kv[tt] = (k1 * cs.y + k2 * cs.x) * 0.125f; }
                    f[tt] = gam;
                } else {
                    qv[tt] = bf2f(*(const LAS bf16_t*)(lds + OFF_RQ + ip * (DK * 2) + d * 2)) * 0.125f; kv[tt] = bf2f(*(const LAS bf16_t*)(lds + OFF_RK + ip * (DK * 2) + d * 2));
                    const float logit = bal + bf2f(*(const LAS bf16_t*)(lds + OFF_RL + ip * 128 + d * 2));
                    const float lg = (fminf(logit, 0.f) - __logf(1.0f + __expf(-fabsf(logit)))) * (1.0f / 16.0f);
                    f[tt] = __expf(lg);
                }
            }
            pl[0] = f[0];
#pragma unroll
            for (int tt = 1; tt < TPG; ++tt) pl[tt] = pl[tt - 1] * f[tt];
            sl[TPG - 1] = 1.0f;
#pragma unroll
            for (int tt = TPG - 2; tt >= 0; --tt) sl[tt] = sl[tt + 1] * f[tt + 1];
        }
        ((LAS float*)(lds + OFF_TOT))[g * DK + d] = pl[TPG - 1];
        __syncthreads();
        if (cn + 1 < 32) { stage_rows(cn + 1, OFF_RQ, cbq, RBQ); stage_rows(cn + 1, OFF_RK, cbk, RBQ); if (MIX == 2) stage_rows(cn + 1, OFF_RL, cbl, 7); }
        {
            unsigned vp[TPGV / 2];
#pragma unroll
            for (int tt = 0; tt < TPGV; tt += 2) { const int ip = gv * TPGV + tt;
                vp[tt >> 1] = (unsigned)*(const LAS bf16_t*)(lds + OFF_RV + ip * (DV * 2) + vv * 2) | ((unsigned)*(const LAS bf16_t*)(lds + OFF_RV + (ip + 1) * (DV * 2) + vv * 2) << 16); }
            float H1 = 1.f, H2 = 1.f, R = 1.f, Fh = 1.f, Gl = 1.f, Gh = 1.f;
#pragma unroll
            for (int gg = 0; gg < TG; ++gg) { const float t = ((LAS float*)(lds + OFF_TOT))[gg * DK + d];
                if (gg < TG / 2) { H1 *= t; if (gg >= g) R *= t; if (gg > g) Gl *= t; }
                else { H2 *= t; if (gg < g) Fh *= t; if (gg > g) Gh *= t; } }
            const float Fg = (g < TG / 2) ? __builtin_amdgcn_rcpf(fmaxf(R, 1e-30f)) : Fh;
            const float Gg = (g < TG / 2) ? Gl : Gh * __builtin_amdgcn_rcpf(fmaxf(H2, 1e-30f));
            if (g == 0) ((LAS float*)(lds + OFF_EL))[d] = H1 * H2;
            unsigned klp[TPG / 2];
#pragma unroll
            for (int tt = 0; tt < TPG; tt += 2) {
                const int ip = g * TPG + tt;
                const float qa = qv[tt] * (pl[tt] * Fg), qb = qv[tt + 1] * (pl[tt + 1] * Fg);
                const float ka = kv[tt] * (sl[tt] * Gg), kb = kv[tt + 1] * (sl[tt + 1] * Gg);
                const unsigned wq = cvt_pk_bf16(qa, qb), wk = cvt_pk_bf16(ka, kb), ws = cvt_pk_bf16(qa * H1, qb * H1);
                *(LAS bf16_t*)(lds + OFF_QT + ip * SQ + d * 2) = (bf16_t)wq; *(LAS bf16_t*)(lds + OFF_QT + (ip + 1) * SQ + d * 2) = (bf16_t)(wq >> 16);
                *(LAS bf16_t*)(lds + OFF_KT + ip * SQ + d * 2) = (bf16_t)wk; *(LAS bf16_t*)(lds + OFF_KT + (ip + 1) * SQ + d * 2) = (bf16_t)(wk >> 16);
                *(LAS bf16_t*)(lds + OFF_QS + ip * SQ + d * 2) = (bf16_t)ws; *(LAS bf16_t*)(lds + OFF_QS + (ip + 1) * SQ + d * 2) = (bf16_t)(ws >> 16);
                klp[tt >> 1] = cvt_pk_bf16(ka * H2, kb * H2);
            }
#pragma unroll
            for (int q = 0; q < TPG / 8; ++q) *(LAS u32x4*)(lds + OFF_KL + d * S64 + (g * TPG + q * 8) * 2) = (u32x4){klp[q * 4], klp[q * 4 + 1], klp[q * 4 + 2], klp[q * 4 + 3]};
#pragma unroll
            for (int q = 0; q < TPGV / 8; ++q) *(LAS u32x4*)(lds + OFF_VT + vv * S64 + (gv * TPGV + q * 8) * 2) = (u32x4){vp[q * 4], vp[q * 4 + 1], vp[q * 4 + 2], vp[q * 4 + 3]};
        }
        __syncthreads();
        if (cn + 1 < 32) stage_rows(cn + 1, OFF_RV, cbv, RBV);
        f32x4 oa[NV];
        {
            f32x4 sc[2] = {(f32x4){0.f, 0.f, 0.f, 0.f}, (f32x4){0.f, 0.f, 0.f, 0.f}};
#pragma unroll
            for (int q = 0; q < NV; ++q) oa[q] = (f32x4){0.f, 0.f, 0.f, 0.f};
#pragma unroll
            for (int ks = 0; ks < DK / 32; ++ks) {
                const bf16x8 bq = *(const LAS bf16x8*)(lds + OFF_QT + (ti * 16 + fr) * SQ + ks * 64 + fq * 16);
#pragma unroll
                for (int jj = 0; jj < 2; ++jj) { const bf16x8 ak = *(const LAS bf16x8*)(lds + OFF_KT + ((tj0 + jj) * 16 + fr) * SQ + ks * 64 + fq * 16);
                    sc[jj] = __builtin_amdgcn_mfma_f32_16x16x32_bf16(ak, bq, sc[jj], 0, 0, 0); }
                const bf16x8 bs = *(const LAS bf16x8*)(lds + OFF_QS + (ti * 16 + fr) * SQ + ks * 64 + fq * 16);
#pragma unroll
                for (int q = 0; q < NV; ++q) { const bf16x8 as = *(const LAS bf16x8*)(lds + OFF_ST + ((tv0 + q) * 16 + fr) * SQ + ks * 64 + fq * 16);
                    oa[q] = __builtin_amdgcn_mfma_f32_16x16x32_bf16(as, bs, oa[q], 0, 0, 0); }
            }
            const int ipc = ti * 16 + fr;
#pragma unroll
            for (int jj = 0; jj < 2; ++jj) { const int jp0 = (tj0 + jj) * 16 + fq * 4; float m[4];
#pragma unroll
                for (int r = 0; r < 4; ++r) { const int jp = jp0 + r; const bool keep = dir ? (jp < ipc) : (jp <= ipc); m[r] = keep ? sc[jj][r] : 0.f; }
                *(LAS u32x2*)(lds + OFF_P + ipc * S64 + jp0 * 2) = (u32x2){cvt_pk_bf16(m[0], m[1]), cvt_pk_bf16(m[2], m[3])}; }
        }
        asm volatile("s_waitcnt vmcnt(0)" ::: "memory");
        __syncthreads();
        {
#pragma unroll
            for (int ks = 0; ks < 2; ++ks) {
                const bf16x8 bp = *(const LAS bf16x8*)(lds + OFF_P + (ti * 16 + fr) * S64 + ks * 64 + fq * 16);
#pragma unroll
                for (int q = 0; q < NV; ++q) { const bf16x8 av = *(const LAS bf16x8*)(lds + OFF_VT + ((tv0 + q) * 16 + fr) * S64 + ks * 64 + fq * 16);
                    oa[q] = __builtin_amdgcn_mfma_f32_16x16x32_bf16(av, bp, oa[q], 0, 0, 0); }
            }
            const int ip = ti * 16 + fr; const int tk = dir ? 63 - ip : ip;
            bf16_t* op = p.o + ((size_t)(dir * 3 + MIX) * MH + bl * SEQ + n * 64 + tk) * 512 + head * 128 + vhalf * 64;
#pragma unroll
            for (int q = 0; q < NV; ++q) *(u32x2*)(op + (tv0 + q) * 16 + fq * 4) = (u32x2){cvt_pk_bf16(oa[q][0], oa[q][1]), cvt_pk_bf16(oa[q][2], oa[q][3])};
        }
#pragma unroll
        for (int q = 0; q < 4; ++q) {
            const int tix = wid * 4 + q, td = tix / (DV / 16), tv = tix % (DV / 16);
            const f32x4 el = *(const LAS f32x4*)(lds + OFF_EL + (td * 16 + fq * 4) * 4);
            S[q] *= el;
#pragma unroll
            for (int ks = 0; ks < 2; ++ks) {
                const bf16x8 ak = *(const LAS bf16x8*)(lds + OFF_KL + (td * 16 + fr) * S64 + ks * 64 + fq * 16);
                const bf16x8 bv = *(const LAS bf16x8*)(lds + OFF_VT + (tv * 16 + fr) * S64 + ks * 64 + fq * 16);
                S[q] = __builtin_amdgcn_mfma_f32_16x16x32_bf16(ak, bv, S[q], 0, 0, 0);
            }
            *(LAS u32x2*)(lds + OFF_ST + (tv * 16 + fr) * SQ + (td * 16 + fq * 4) * 2) = (u32x2){cvt_pk_bf16(S[q][0], S[q][1]), cvt_pk_bf16(S[q][2], S[q][3])};
        }
    }
    asm volatile("s_waitcnt vmcnt(0)" ::: "memory");
    __syncthreads();
}
__device__ void phase_scan(const Params& p, LAS unsigned char* lds, int layer) {
    for (int item = blockIdx.x; item < 256; item += gridDim.x) {
        if (item < 128) { const int vhalf = item & 1, dir = (item >> 1) & 1, head = (item >> 2) & 3, bl = item >> 4; scan_item<128, 64, 0>(p, lds, layer, bl, head, dir, vhalf); }
        else if (item < 192) { const int i = item - 128, dir = i & 1, head = (i >> 1) & 3, bl = i >> 3; scan_item<64, 128, 1>(p, lds, layer, bl, head, dir, 0); }
        else { const int i = item - 192, dir = i & 1, head = (i >> 1) & 3, bl = i >> 3; scan_item<64, 128, 2>(p, lds, layer, bl, head, dir, 0); }
    }
}

__device__ void phase_ypass(const Params& p, int layer) {
    int tid_ = threadIdx.x; asm volatile("" : "+v"(tid_));
    const int lane = tid_ & 63, wid = tid_ >> 6;
    const int ch = (lane >> 4) * 128 + (lane & 15) * 8;
    f32x4 gn[3][2];
#pragma unroll
    for (int br = 0; br < 3; ++br) { const float* g = (br == 0 ? p.norm_a_g : br == 1 ? p.norm_b_g : p.norm_c_g) + layer * 512 + ch; gn[br][0] = *(const f32x4*)g; gn[br][1] = *(const f32x4*)(g + 4); }
    for (int rg = blockIdx.x; rg < MH / 16; rg += gridDim.x) {
        u32x4 a[2][3], b[2][3], gz[2][3];
#pragma unroll
        for (int t = 0; t < 2; ++t) { const int tok = rg * 16 + t * 8 + wid; const bf16_t* zr = p.z + (size_t)tok * NZ;
#pragma unroll
            for (int br = 0; br < 3; ++br) {
                a[t][br] = *(const u32x4*)(p.o + ((size_t)br * MH + tok) * 512 + ch);
                b[t][br] = *(const u32x4*)(p.o + ((size_t)(3 + br) * MH + tok) * 512 + ch);
                gz[t][br] = *(const u32x4*)(zr + (br == 0 ? ZA_G : br == 1 ? ZB_G : ZC_G) + ch); } }
#pragma unroll
        for (int t = 0; t < 2; ++t) { const int tok = rg * 16 + t * 8 + wid;
#pragma unroll
            for (int br = 0; br < 3; ++br) {
                float s[8], gt[8];
#pragma unroll
                for (int e = 0; e < 4; ++e) {
                    s[2 * e] = __uint_as_float(a[t][br][e] << 16) + __uint_as_float(b[t][br][e] << 16);
                    s[2 * e + 1] = __uint_as_float(a[t][br][e] & 0xffff0000u) + __uint_as_float(b[t][br][e] & 0xffff0000u);
                    gt[2 * e] = __uint_as_float(gz[t][br][e] << 16); gt[2 * e + 1] = __uint_as_float(gz[t][br][e] & 0xffff0000u); }
                float mu = 0.f;
                if (br == 1) {
#pragma unroll
                    for (int j = 0; j < 8; ++j) mu += s[j];
#pragma unroll
                    for (int m = 8; m >= 1; m >>= 1) mu += __shfl_xor(mu, m);
                    mu *= (1.0f / 128.0f);
                }
                float ss = 0.f;
#pragma unroll
                for (int j = 0; j < 8; ++j) { s[j] -= mu; ss += s[j] * s[j]; }
#pragma unroll
                for (int m = 8; m >= 1; m >>= 1) ss += __shfl_xor(ss, m);
                const float rstd = rsqrtf(ss * (1.0f / 128.0f) + 1e-6f);
                float r[8];
#pragma unroll
                for (int j = 0; j < 8; ++j) { const float gn_ = gn[br][j >> 2][j & 3]; const float sg = sigmoidf_(gt[j]);
                    const float act = br == 0 ? sg : gt[j] * sg; r[j] = s[j] * rstd * gn_ * act; }
                *(u32x4*)(p.o + ((size_t)br * MH + tok) * 512 + ch) = (u32x4){cvt_pk_bf16(r[0], r[1]), cvt_pk_bf16(r[2], r[3]), cvt_pk_bf16(r[4], r[5]), cvt_pk_bf16(r[6], r[7])};
            } }
    }
}

#define XB_TMO      128
#define XB_XCNT(j)  (256  + 64 * (j))
#define XB_XSUB(j)  (1280 + 64 * (j))
#define XB_XGEN(j)  (2304 + 64 * (j))
#define XB_TOP      3328
#define XB_TOPGEN   3392
#define XCD_BAR_WORDS 3456
#define XB_SPIN_CAP (1u << 22)
__device__ __forceinline__ unsigned xb_ld(unsigned* p)              { return __hip_atomic_load(p, __ATOMIC_RELAXED, __HIP_MEMORY_SCOPE_AGENT); }
__device__ __forceinline__ unsigned xb_add(unsigned* p, unsigned v) { return __hip_atomic_fetch_add(p, v, __ATOMIC_RELAXED, __HIP_MEMORY_SCOPE_AGENT); }
__device__ __forceinline__ unsigned xb_xcc_id() { return (unsigned)__builtin_amdgcn_s_getreg((3 << 11) | 20) & 0xFu; }
#define XB_SPIN(cond, bar) do { unsigned _sp = 0; while (cond) { __builtin_amdgcn_s_sleep(1); \
    if ((++_sp & 255u) == 0u) { if (xb_ld(&(bar)[XB_TMO])) break; if (_sp > XB_SPIN_CAP) { atomicAdd(&(bar)[XB_TMO], 1u); break; } } } } while (0)
struct XcdBarrier { unsigned* bar; unsigned x; volatile LAS unsigned* st; };
__device__ __forceinline__ XcdBarrier xcd_barrier_post(unsigned* bar, volatile LAS unsigned* st) {
    XcdBarrier b; b.bar = bar; b.x = xb_xcc_id(); b.st = st;
    if (threadIdx.x == 0) (void)xb_add(&bar[XB_XCNT(b.x)], 1u);
    return b;
}
__device__ __forceinline__ void xcd_barrier_complete(unsigned* bar, unsigned x, unsigned& nloc, unsigned& nx) {
    const unsigned G = gridDim.x * gridDim.y * gridDim.z;
    unsigned sum, cnt, mine, sp = 0u;
    for (;;) {
        sum = 0u; cnt = 0u; mine = 0u;
#pragma unroll
        for (unsigned j = 0; j < 16; ++j) { const unsigned c = xb_ld(&bar[XB_XCNT(j)]); sum += c; cnt += (c > 0u) ? 1u : 0u; mine = (j == x) ? c : mine; }
        if (sum == G) break;
        __builtin_amdgcn_s_sleep(1);
        if ((++sp & 255u) == 0u) { if (xb_ld(&bar[XB_TMO])) break; if (sp > XB_SPIN_CAP) { atomicAdd(&bar[XB_TMO], 1u); break; } }
    }
    nloc = mine > 0u ? mine : 1u; nx = cnt > 0u ? cnt : 1u;
}
__device__ __forceinline__ void xcd_barrier(const XcdBarrier& b) {
    asm volatile("s_waitcnt vmcnt(0)" ::: "memory");
    __syncthreads();
    if (threadIdx.x == 0) {
        unsigned* bar = b.bar;
        __builtin_amdgcn_s_waitcnt(0);
        unsigned nloc = b.st[0], nx = b.st[1];
        if (nloc == 0u) { xcd_barrier_complete(bar, b.x, nloc, nx); b.st[0] = nloc; b.st[1] = nx; }
        const unsigned old = xb_add(&bar[XB_XSUB(b.x)], 1u);
        const unsigned gen = old / nloc;
        if (old + 1u == (gen + 1u) * nloc) {
            __builtin_amdgcn_fence(__ATOMIC_RELEASE, "agent");
            asm volatile("s_waitcnt vmcnt(0)" ::: "memory");
            const unsigned og = xb_add(&bar[XB_TOP], 1u);
            const unsigned tg = og / nx;
            if (og + 1u == (tg + 1u) * nx) xb_add(&bar[XB_TOPGEN], 1u);
            else XB_SPIN(xb_ld(&bar[XB_TOPGEN]) == tg, bar);
            __builtin_amdgcn_fence(__ATOMIC_ACQUIRE, "agent");
            xb_add(&bar[XB_XGEN(b.x)], 1u);
            asm volatile("s_waitcnt vmcnt(0)" ::: "memory");
        } else {
            XB_SPIN(xb_ld(&bar[XB_XGEN(b.x)]) == gen, bar);
            __builtin_amdgcn_fence(__ATOMIC_ACQUIRE, "agent");
            asm volatile("s_waitcnt vmcnt(0)" ::: "memory");
        }
    }
    __syncthreads();
}

constexpr int N_PHASES = 1 + DEPTH * (1 + 1 + NGRP * 4 + 3) + 1;

__global__ void __launch_bounds__(512, 2) mega(Params p, int ph0, int ph1) {
    extern __shared__ __attribute__((aligned(16))) unsigned char shm[];
    LAS unsigned char* lds = (LAS unsigned char*)shm;
    cg::grid_group grid = cg::this_grid();
    volatile LAS unsigned* xst = (volatile LAS unsigned*)(lds + LDS_MAIN);
    if (threadIdx.x == 0) { xst[0] = 0u; xst[1] = 0u; }
    __syncthreads();
    const XcdBarrier xb = xcd_barrier_post(p.bar, xst);
    int pc = 0;
#define PHASE_BEGIN if (pc >= ph0 && pc < ph1) {
#define PHASE_END   if (pc + 1 < ph1) { if (ph1 < 0) grid.sync(); else xcd_barrier(xb); } } ++pc;
    PHASE_BEGIN
        phase_prologue(p, lds);
        phase_conv(p, lds, 0);
    PHASE_END
    for (int l = 0; l < DEPTH; ++l) {
        const float* modL = p.mod + (size_t)l * BATCH * (6 * D);
        const float* xinL = (l == 0 ? p.x : p.out);
        PHASE_BEGIN
            if (l > 0) phase_conv(p, lds, l);
            phase_norm(xinL, p.norm1_g + l * D, modL, 0, D, p.h, 2 * MH);
        PHASE_END
        for (int grp = 0; grp < NGRP; ++grp) {
            const float* modg = modL + (size_t)grp * GB * (6 * D);
            float* xg = p.out + (size_t)grp * MH * D;
            const float* xin0 = xinL + (size_t)grp * MH * D;
            bf16_t* hg = p.h + (size_t)grp * MH * D;
            if (grp == 0) {
            PHASE_BEGIN
                pg8::Gemm g{hg, p.wt_in, D, D, D}; pg8::ProjOrder S; S.base.init(MH, NZ, gridDim.x, blockIdx.x);
                pg8::EpiZ E{p.z, NZ}; pg8::gemm_phase(lds, g, S, E);
            PHASE_END
            }
            PHASE_BEGIN
                phase_scan(p, lds, l);
            PHASE_END
            PHASE_BEGIN
                phase_ypass(p, l);
            PHASE_END
            PHASE_BEGIN
                pg8::Gemm g{p.o, p.wt_p, 512, 512, 512}; pg8::MergeOrder S; S.base.init(MH, D, gridDim.x, blockIdx.x);
                pg8::EpiMerge E{p.z, hg}; pg8::gemm_phase(lds, g, S, E);
            PHASE_END
            PHASE_BEGIN
                { pg8::Gemm g{hg, p.wt_out, D, D, D}; pg8::StaticOrder S; S.init(MH, D, gridDim.x, blockIdx.x);
                  pg8::EpiRes E{xin0, xg, modg + 2 * D}; pg8::gemm_phase(lds, g, S, E); }
                if (grp == 0) {
                    pg8::Gemm g{p.h + (size_t)MH * D, p.wt_in, D, D, D}; pg8::ProjOrder S; S.base.init(MH, NZ, gridDim.x, blockIdx.x);
                    pg8::EpiZ E{p.z, NZ}; pg8::gemm_phase(lds, g, S, E);
                }
            PHASE_END
        }
        {
            const float* modl = p.mod + (size_t)l * BATCH * (6 * D);
            PHASE_BEGIN
                phase_norm(p.out, p.norm2_g + l * D, modl, 3 * D, 4 * D, p.h2, 2 * MH);
            PHASE_END
            PHASE_BEGIN
                pg8::Gemm g{p.h2, p.wt_fi, D, D, D}; pg8::StaticOrder S; S.init(2 * MH, 2 * DFF, gridDim.x, blockIdx.x);
                pg8::EpiAct E{p.z, DFF}; pg8::gemm_phase(lds, g, S, E);
            PHASE_END
            PHASE_BEGIN
                pg8::Gemm g{p.z, p.wt_fo, DFF, DFF, DFF}; pg8::StaticOrder S; S.init(2 * MH, D, gridDim.x, blockIdx.x);
                pg8::EpiRes E{p.out, p.out, modl + 5 * D}; pg8::gemm_phase(lds, g, S, E);
            PHASE_END
        }
    }
    PHASE_BEGIN
        phase_final(p);
    PHASE_END
}

extern "C" void kernel_launch(void* const* d_in, const int* in_sizes, int n_in, void* d_out, int out_size, void* d_ws, size_t ws_size, hipStream_t stream) {
    Params p{};
    const float** f = (const float**)&p;
    for (int i = 0; i < 20; ++i) f[i] = (const float*)d_in[i];
    p.out = (float*)d_out;
    char* w = (char*)d_ws; size_t off = 0;
    auto take = [&](size_t bytes) { char* r = w + off; off += (bytes + 255) & ~(size_t)255; return r; };
    p.wt_in = (bf16_t*)take((size_t)NZ * D * 2);
    p.wt_p = (bf16_t*)take((size_t)3 * D * 512 * 2);
    p.wt_out = (bf16_t*)take((size_t)D * D * 2);
    p.wt_fi = (bf16_t*)take((size_t)2 * DFF * D * 2);
    p.wt_fo = (bf16_t*)take((size_t)D * DFF * 2);
    p.mod = (float*)take((size_t)DEPTH * BATCH * 6 * D * 4);
    p.lb = (float*)take((size_t)DEPTH * 512 * 4);
    p.rope = (float2*)take((size_t)SEQ * 32 * 8);
    p.h = (bf16_t*)take((size_t)2 * MH * D * 2);
    p.h2 = p.h;
    p.z = (bf16_t*)take((size_t)MH * NZ * 2);
    p.o = (bf16_t*)take((size_t)2 * 3 * MH * 512 * 2);
    p.bar = (unsigned*)take((size_t)XCD_BAR_WORDS * 4);
    if (off > ws_size) { fprintf(stderr, "workspace too small: need %zu have %zu\n", off, ws_size); return; }
    static int grid_blocks = 0;
    if (!grid_blocks) {
        (void)hipFuncSetAttribute((const void*)mega, hipFuncAttributeMaxDynamicSharedMemorySize, LDS_BYTES);
        int dev = 0, cus = 0, per_cu = 0;
        (void)hipGetDevice(&dev);
        (void)hipDeviceGetAttribute(&cus, hipDeviceAttributeMultiprocessorCount, dev);
        (void)hipOccupancyMaxActiveBlocksPerMultiprocessor(&per_cu, mega, 512, LDS_BYTES);
        if (per_cu < 1) per_cu = 1;
        grid_blocks = cus * 1;
    }
    (void)hipMemsetAsync(p.bar, 0, (size_t)XCD_BAR_WORDS * 4, stream);
#if MULTI_LAUNCH
    for (int ph = 0; ph < N_PHASES; ++ph)
        hipLaunchKernelGGL(mega, dim3(grid_blocks), dim3(512), LDS_BYTES, stream, p, ph, ph + 1);
#else
    int ph0 = 0, ph1 = N_PHASES;
    void* args[] = {&p, &ph0, &ph1};
    hipError_t e = hipLaunchCooperativeKernel((void*)mega, dim3(grid_blocks), dim3(512), args, LDS_BYTES, stream);
    if (e != hipSuccess) fprintf(stderr, "cooperative launch failed: %s (grid %d)\n", hipGetErrorString(e), grid_blocks);
#endif
}
```

```cpp
#include <hip/hip_runtime.h>
#include <hip/hip_cooperative_groups.h>
#include <cstdio>
namespace cg = cooperative_groups;

#ifndef MULTI_LAUNCH
#define MULTI_LAUNCH 0
#endif

#define LAS __attribute__((address_space(3)))
typedef unsigned short bf16_t;
typedef short bf16x8 __attribute__((ext_vector_type(8)));
typedef float f32x4 __attribute__((ext_vector_type(4)));
typedef unsigned u32x4 __attribute__((ext_vector_type(4)));
typedef unsigned u32x2 __attribute__((ext_vector_type(2)));

constexpr int D = 1024, BATCH = 16, SEQ = 2048, DEPTH = 4;
constexpr int GB = 8;
constexpr int NGRP = BATCH / GB;
constexpr int MH = GB * SEQ;
constexpr int NIN = 8736, NZ = 9216, DFF = 2816;
constexpr int LDS_MAIN = 155648;
constexpr int LDS_BYTES = LDS_MAIN + 16;
constexpr int ZA_Q = 0, ZA_FF = 512, ZA_FB = 1024, ZA_I = 1536, ZA_G = 2048;
constexpr int ZB_Q = 2560, ZB_K = 2816, ZB_V = 3072, ZB_G = 3584;
constexpr int ZC_Q = 4096, ZC_K = 4352, ZC_V = 4608, ZC_G = 5120, ZC_LG = 8704;
constexpr int ZG_A = 5632;

struct Params {
    const float *x, *c, *norm1_g, *w_ada, *b_ada, *w_in, *lb_logits, *norm_a_g, *norm_b_g, *norm_c_g, *w_alpha, *b_alpha,
                *w_pa, *w_pb, *w_pc, *w_out, *norm2_g, *w_ffn_in, *w_ffn_out, *norm_f_g;
    float* out;
    bf16_t *wt_in;
    bf16_t *wt_p;
    bf16_t *wt_out;
    bf16_t *wt_fi;
    bf16_t *wt_fo;
    float *mod;
    float *lb;
    float2 *rope;
    bf16_t *h;
    bf16_t *h2;
    bf16_t *z;
    bf16_t *o;
    unsigned *bar;
};

__device__ __forceinline__ float bf2f(bf16_t h) { return __uint_as_float(((unsigned)h) << 16); }
__device__ __forceinline__ bf16_t f2bf(float f) { unsigned u = __float_as_uint(f); u += 0x7fffu + ((u >> 16) & 1u); return (bf16_t)(u >> 16); }
__device__ __forceinline__ unsigned pk2(float lo, float hi) { return (unsigned)f2bf(lo) | ((unsigned)f2bf(hi) << 16); }
typedef __bf16 bf16x2_t __attribute__((ext_vector_type(2)));
typedef float f32x2_t __attribute__((ext_vector_type(2)));
__device__ __forceinline__ unsigned cvt_pk_bf16(float lo, float hi) { const f32x2_t f = {lo, hi}; const bf16x2_t v = __builtin_convertvector(f, bf16x2_t); return __builtin_bit_cast(unsigned, v); }
__device__ __forceinline__ float sigmoidf_(float x) { return __builtin_amdgcn_rcpf(1.0f + __expf(-x)); }
__device__ __forceinline__ float clampf(float x, float lo, float hi) { return fminf(fmaxf(x, lo), hi); }

namespace pg8 {
constexpr int BM = 256, BK = 64, HALF = 128, HTB = HALF * BK * 2, STAGE_BYTES = 8 * HTB, NXCD = 8, WGM = 8;
__host__ __device__ __forceinline__ int lds_byte(int r, int c) { const int st = (r >> 4) * 2 + (c >> 5), rr = r & 15, cc = c & 31, ob = rr * 64 + cc * 2; return st * 1024 + (ob ^ (((ob >> 9) & 1) << 5)); }
__host__ __device__ __forceinline__ void stage_rc(int b, int& R, int& C) { const int st = b / 1024, sb = b % 1024, swz = sb ^ (((sb >> 9) & 1) << 5); R = (st >> 1) * 16 + swz / 64; C = (st & 1) * 32 + (swz % 64) / 2; }
__host__ __device__ __forceinline__ int perm32(int rho) { const int n = rho >> 4, i = rho & 15; return 8 * (i >> 2) + 4 * n + (i & 3); }

struct Unit { int pm, pn; };
struct Gemm { const bf16_t* A; const bf16_t* Bt; int lda, ldb, K; };

struct StaticOrder {
    int nM, nN, nwg, G, c;
    __device__ void init(int M, int N, int G_, int c_) { nM = M / BM; nN = N / BM; nwg = nM * nN; G = G_; c = c_; }
    __device__ bool next(int i, Unit& u) const {
        const long L = (long)i * G + c; if (L >= nwg) return false;
        int wgid = (int)L; { const int q = nwg / NXCD, r = nwg % NXCD, xcd = wgid % NXCD, off = wgid / NXCD; wgid = (xcd < r ? xcd * (q + 1) : r * (q + 1) + (xcd - r) * q) + off; }
        const int nig = WGM * nN, gid = wgid / nig, fm = gid * WGM, gsz = (nM - fm) < WGM ? (nM - fm) : WGM;
        u.pm = fm + ((wgid % nig) % gsz); u.pn = (wgid % nig) / gsz; return true;
    }
};
struct ProjOrder {
    StaticOrder base;
    __device__ bool next(int i, Unit& u) const { if (!base.next(i, u)) return false; u.pn = (u.pn + 22) % 36; return true; }
};
struct MergeOrder {
    StaticOrder base;
    __device__ bool next(int i, Unit& u) const { Unit t; if (!base.next(i / 3, t)) return false; const int br = i % 3; u.pm = br * (MH / BM) + t.pm; u.pn = br * (D / BM) + t.pn; return true; }
};

typedef f32x4 Acc[2][2][4][2];
__device__ __forceinline__ void zero_acc(Acc& acc) {
#pragma unroll
    for (int a = 0; a < 2; ++a)
#pragma unroll
        for (int b = 0; b < 2; ++b)
#pragma unroll
            for (int m = 0; m < 4; ++m)
#pragma unroll
                for (int n = 0; n < 2; ++n) acc[a][b][m][n] = (f32x4){0.f, 0.f, 0.f, 0.f};
}

struct EpiZ {
    static constexpr bool PERM = true;
    bf16_t* O; int ldc;
    template <int MODE  >
    __device__ __forceinline__ void body(Acc& acc, int row0, int col0) const {
#pragma unroll
        for (int ai = 0; ai < 2; ++ai)
#pragma unroll
            for (int m = 0; m < 4; ++m) { bf16_t* rowp = O + (size_t)(row0 + ai * HALF + m * 16) * ldc + col0;
#pragma unroll
                for (int bj = 0; bj < 2; ++bj) { f32x4 v0 = acc[ai][bj][m][0], v1 = acc[ai][bj][m][1];
                    if (MODE == 1) {
#pragma unroll
                        for (int j = 0; j < 4; ++j) { v0[j] *= sigmoidf_(v0[j]); v1[j] *= sigmoidf_(v1[j]); } }
                    if (MODE == 2) {
#pragma unroll
                        for (int j = 0; j < 4; ++j) { v0[j] = sigmoidf_(v0[j]); v1[j] = sigmoidf_(v1[j]); } }
                    u32x4 w; w.x = cvt_pk_bf16(v0[0], v0[1]); w.y = cvt_pk_bf16(v0[2], v0[3]); w.z = cvt_pk_bf16(v1[0], v1[1]); w.w = cvt_pk_bf16(v1[2], v1[3]);
                    *(u32x4*)(rowp + bj * HALF) = w; } }
    }
    __device__ __forceinline__ void operator()(Acc& acc, const Unit& u, int wr, int wc, int fr, int fq) const {
        const int row0 = u.pm * BM + wr * 64 + fr, col0 = u.pn * BM + wc * 32 + 8 * fq;
        if (u.pn < 2) body<1>(acc, row0, col0);
        else if ((u.pn >= 2 && u.pn < 6) || (u.pn >= 22 && u.pn < 34)) body<2>(acc, row0, col0);
        else body<0>(acc, row0, col0);
        zero_acc(acc);
    }
};
struct EpiAct {
    static constexpr bool PERM = true;
    bf16_t* O; int ldc;
    __device__ __forceinline__ void operator()(Acc& acc, const Unit& u, int wr, int wc, int fr, int fq) const {
        const int row0 = u.pm * BM + wr * 64 + fr, col0 = u.pn * HALF + wc * 32 + 8 * fq;
#pragma unroll
        for (int ai = 0; ai < 2; ++ai)
#pragma unroll
            for (int m = 0; m < 4; ++m) { bf16_t* rowp = O + (size_t)(row0 + ai * HALF + m * 16) * ldc + col0;
                float r[8];
#pragma unroll
                for (int n = 0; n < 2; ++n)
#pragma unroll
                    for (int j = 0; j < 4; ++j) { const float g = acc[ai][0][m][n][j], up = acc[ai][1][m][n][j]; r[n * 4 + j] = g * sigmoidf_(g) * up; }
                u32x4 w; w.x = cvt_pk_bf16(r[0], r[1]); w.y = cvt_pk_bf16(r[2], r[3]); w.z = cvt_pk_bf16(r[4], r[5]); w.w = cvt_pk_bf16(r[6], r[7]);
                *(u32x4*)rowp = w; }
        zero_acc(acc);
    }
};
struct EpiRes {
    static constexpr bool PERM = true;
    const float* xin; float* xout; const float* gm;
    __device__ __forceinline__ void operator()(Acc& acc, const Unit& u, int wr, int wc, int fr, int fq) const {
        const int row0 = u.pm * BM + wr * 64 + fr, col0 = u.pn * BM + wc * 32 + 8 * fq;
        const float* gb = gm + (size_t)((u.pm * BM) / SEQ) * (6 * D);
        f32x4 gv[2][2];
#pragma unroll
        for (int bj = 0; bj < 2; ++bj)
#pragma unroll
            for (int n = 0; n < 2; ++n) gv[bj][n] = *(const f32x4*)(gb + col0 + bj * HALF + n * 4);
#pragma unroll
        for (int ai = 0; ai < 2; ++ai) {
            f32x4 xi[4][2][2];
#pragma unroll
            for (int m = 0; m < 4; ++m) { const size_t off = (size_t)(row0 + ai * HALF + m * 16) * D + col0;
#pragma unroll
                for (int bj = 0; bj < 2; ++bj)
#pragma unroll
                    for (int n = 0; n < 2; ++n) xi[m][bj][n] = *(const f32x4*)(xin + off + bj * HALF + n * 4); }
#pragma unroll
            for (int m = 0; m < 4; ++m) { const size_t off = (size_t)(row0 + ai * HALF + m * 16) * D + col0;
#pragma unroll
                for (int bj = 0; bj < 2; ++bj)
#pragma unroll
                    for (int n = 0; n < 2; ++n) *(f32x4*)(xout + off + bj * HALF + n * 4) = xi[m][bj][n] + gv[bj][n] * acc[ai][bj][m][n]; }
        }
        zero_acc(acc);
    }
};
struct EpiMerge {
    static constexpr bool PERM = true;
    const bf16_t* z; bf16_t* O;
    __device__ __forceinline__ void operator()(Acc& acc, const Unit& u, int wr, int wc, int fr, int fq) const {
        const int br = u.pm / (MH / BM), pm = u.pm - br * (MH / BM), pn = u.pn - br * (D / BM);
        const int row0 = pm * BM + wr * 64 + fr, col0 = pn * BM + wc * 32 + 8 * fq;
        const bf16_t* zg = z + ZG_A + br * D + col0;
#pragma unroll
        for (int ai = 0; ai < 2; ++ai) {
            u32x4 g0[4][2], g1[4][2];
#pragma unroll
            for (int m = 0; m < 4; ++m) { const size_t row = (size_t)(row0 + ai * HALF + m * 16);
#pragma unroll
                for (int bj = 0; bj < 2; ++bj) { g0[m][bj] = *(const u32x4*)(zg + row * NZ + bj * HALF);
                    if (br < 2) g1[m][bj] = *(const u32x4*)(zg + row * NZ + D + bj * HALF); } }
#pragma unroll
            for (int m = 0; m < 4; ++m) { const size_t row = (size_t)(row0 + ai * HALF + m * 16);
#pragma unroll
                for (int bj = 0; bj < 2; ++bj) {
                    float s[8];
                    if (br < 2) {
#pragma unroll
                        for (int e = 0; e < 4; ++e) {
                            const float a0 = __uint_as_float(g0[m][bj][e] << 16), a1 = __uint_as_float(g0[m][bj][e] & 0xffff0000u);
                            const float b0 = __uint_as_float(g1[m][bj][e] << 16), b1 = __uint_as_float(g1[m][bj][e] & 0xffff0000u);
                            s[2 * e] = a0 * __builtin_amdgcn_rcpf(fmaxf(b0, 1e-30f)); s[2 * e + 1] = a1 * __builtin_amdgcn_rcpf(fmaxf(b1, 1e-30f)); }
#pragma unroll
                        for (int n = 0; n < 2; ++n)
#pragma unroll
                            for (int j = 0; j < 4; ++j) acc[ai][bj][m][n][j] *= s[n * 4 + j];
                    } else {
#pragma unroll
                        for (int e = 0; e < 4; ++e) { s[2 * e] = __uint_as_float(g0[m][bj][e] << 16); s[2 * e + 1] = __uint_as_float(g0[m][bj][e] & 0xffff0000u); }
                        const f32x4 v0 = acc[ai][bj][m][0], v1 = acc[ai][bj][m][1];
                        u32x4 w; w.x = cvt_pk_bf16(v0[0] * s[0], v0[1] * s[1]); w.y = cvt_pk_bf16(v0[2] * s[2], v0[3] * s[3]);
                        w.z = cvt_pk_bf16(v1[0] * s[4], v1[1] * s[5]); w.w = cvt_pk_bf16(v1[2] * s[6], v1[3] * s[7]);
                        *(u32x4*)(O + row * D + col0 + bj * HALF) = w;
                        acc[ai][bj][m][0] = (f32x4){0.f, 0.f, 0.f, 0.f}; acc[ai][bj][m][1] = (f32x4){0.f, 0.f, 0.f, 0.f};
                    } } }
        }
    }
};

template <class Epi, class Sched>
__device__ __forceinline__ void gemm_phase(LAS unsigned char* lds, const Gemm g, const Sched& S, const Epi& E) {
    int tid_ = threadIdx.x; asm volatile("" : "+v"(tid_));
    const int tid = tid_, wid = __builtin_amdgcn_readfirstlane(tid >> 6), lane = tid & 63, wr = wid >> 2, wc = wid & 3, fr = lane & 15, fq = lane >> 4;
    const int K = g.K, nt = K / BK;
    unsigned voffA[2], voffB[2];
#pragma unroll
    for (int i = 0; i < 2; ++i) { int R, C; stage_rc(tid * 16 + i * 8192, R, C); const int Rb = Epi::PERM ? ((R & ~31) + perm32(R & 31)) : R;
        voffA[i] = (unsigned)(R * g.lda + C) * 2u; voffB[i] = (unsigned)(Rb * g.ldb + C) * 2u; }
    const size_t kstep = (size_t)(BK * 2);
    const size_t hstepA = (size_t)HALF * g.lda * 2, hstepB = (size_t)HALF * g.ldb * 2;
    const size_t tstepA = 2 * hstepA, tstepB = 2 * hstepB;
    const unsigned ldsw = (unsigned)wid * 1024u;
    const int aoff = lds_byte(wr * 64 + fr, fq * 8), boff = lds_byte(wc * 32 + fr, fq * 8);
#define PG8_SA(b, h) (((b) * 2 + (h)) * HTB)
#define PG8_SB(b, h) ((4 + (b) * 2 + (h)) * HTB)
#define PG8_STAGE(bufoff, gbase, voff) do { _Pragma("unroll") for (int _i = 0; _i < 2; ++_i) \
        __builtin_amdgcn_global_load_lds((const unsigned*)((const char*)(gbase) + (voff)[_i]), (LAS unsigned*)(lds + (bufoff) + ldsw + _i * 8192), 16, 0, 0); } while (0)
#define PG8_LDA(dst, b, h) do { _Pragma("unroll") for (int m = 0; m < 4; ++m) _Pragma("unroll") for (int k = 0; k < 2; ++k) dst[m][k] = *(const LAS bf16x8*)(lds + PG8_SA(b, h) + aoff + m * 2048 + k * 1024); } while (0)
#define PG8_LDB(dst, b, h) do { _Pragma("unroll") for (int n = 0; n < 2; ++n) _Pragma("unroll") for (int k = 0; k < 2; ++k) dst[n][k] = *(const LAS bf16x8*)(lds + PG8_SB(b, h) + boff + n * 2048 + k * 1024); } while (0)
#define PG8_MMA(ai, bj, At, Bt) do { __builtin_amdgcn_s_setprio(1); _Pragma("unroll") for (int m = 0; m < 4; ++m) _Pragma("unroll") for (int n = 0; n < 2; ++n) _Pragma("unroll") for (int k = 0; k < 2; ++k) \
        acc[ai][bj][m][n] = __builtin_amdgcn_mfma_f32_16x16x32_bf16(Bt[n][k], At[m][k], acc[ai][bj][m][n], 0, 0, 0); __builtin_amdgcn_s_setprio(0); } while (0)
#define PG8_WAIT_V(n) asm volatile("s_waitcnt vmcnt(" #n ")" ::: "memory")
#define PG8_WAIT_L(n) asm volatile("s_waitcnt lgkmcnt(" #n ")" ::: "memory")
#define PG8_BAR __builtin_amdgcn_s_barrier()
#define PG8_SCHED __builtin_amdgcn_sched_barrier(0)
    Unit cur, nxt; int ui = 0;
    if (!S.next(0, cur)) return;
    Acc acc; zero_acc(acc);
    bf16x8 At[4][2], B0[2][2], B1[2][2];
    const char* cA = (const char*)g.A + (size_t)cur.pm * tstepA; const char* cB = (const char*)g.Bt + (size_t)cur.pn * tstepB;
    PG8_STAGE(PG8_SB(0, 0), cB, voffB); PG8_STAGE(PG8_SA(0, 0), cA, voffA); PG8_STAGE(PG8_SB(0, 1), cB + hstepB, voffB); PG8_STAGE(PG8_SA(0, 1), cA + hstepA, voffA);
    if (wr == 1) PG8_BAR;
    PG8_WAIT_V(4); PG8_BAR;
    PG8_STAGE(PG8_SB(1, 0), cB + kstep, voffB); PG8_STAGE(PG8_SA(1, 0), cA + kstep, voffA); PG8_STAGE(PG8_SB(1, 1), cB + hstepB + kstep, voffB);
    PG8_WAIT_V(6); PG8_BAR;
    for (;;) {
        const bool has_next = S.next(ui + 1, nxt);
        const char* nA = has_next ? (const char*)g.A + (size_t)nxt.pm * tstepA : cA; const char* nB = has_next ? (const char*)g.Bt + (size_t)nxt.pn * tstepB : cB;
        for (int t = 0; t < nt; t += 2) {
            const bool last = (t == nt - 2);
            const char* a1 = cA + (size_t)(t + 1) * kstep;
            const char* a2 = last ? nA : cA + (size_t)(t + 2) * kstep; const char* b2 = last ? nB : cB + (size_t)(t + 2) * kstep;
            const char* a3 = a2 + kstep; const char* b3 = b2 + kstep;
            PG8_LDB(B0, 0, 0); PG8_SCHED; PG8_LDA(At, 0, 0); PG8_STAGE(PG8_SA(1, 1), a1 + hstepA, voffA);
            PG8_WAIT_L(8); PG8_BAR; PG8_WAIT_L(0); PG8_MMA(0, 0, At, B0); PG8_BAR; PG8_SCHED;
            PG8_LDB(B1, 0, 1); PG8_STAGE(PG8_SB(0, 0), b2, voffB);
            PG8_BAR; PG8_WAIT_L(0); PG8_MMA(0, 1, At, B1); PG8_BAR;
            PG8_LDA(At, 0, 1); PG8_STAGE(PG8_SA(0, 0), a2, voffA);
            PG8_BAR; PG8_WAIT_L(0); PG8_MMA(1, 0, At, B0); PG8_BAR; PG8_SCHED;
            PG8_STAGE(PG8_SB(0, 1), b2 + hstepB, voffB);
            PG8_WAIT_V(6); PG8_BAR; PG8_MMA(1, 1, At, B1); PG8_BAR;
            PG8_LDB(B0, 1, 0); PG8_SCHED; PG8_LDA(At, 1, 0); PG8_STAGE(PG8_SA(0, 1), a2 + hstepA, voffA);
            PG8_WAIT_L(8); PG8_BAR; PG8_WAIT_L(0); PG8_MMA(0, 0, At, B0); PG8_BAR; PG8_SCHED;
            PG8_LDB(B1, 1, 1); PG8_STAGE(PG8_SB(1, 0), b3, voffB);
            PG8_BAR; PG8_WAIT_L(0); PG8_MMA(0, 1, At, B1); PG8_BAR;
            PG8_LDA(At, 1, 1); PG8_STAGE(PG8_SA(1, 0), a3, voffA);
            PG8_BAR; PG8_WAIT_L(0); PG8_MMA(1, 0, At, B0); PG8_BAR; PG8_SCHED;
            PG8_STAGE(PG8_SB(1, 1), b3 + hstepB, voffB);
            PG8_WAIT_V(6); PG8_BAR; PG8_MMA(1, 1, At, B1); PG8_BAR;
        }
        E(acc, cur, wr, wc, fr, fq);
        if (!has_next) break;
        cur = nxt; cA = nA; cB = nB; ++ui;
    }
    PG8_WAIT_V(0);
    if (wr == 0) PG8_BAR;
    PG8_BAR;
#undef PG8_SA
#undef PG8_SB
#undef PG8_STAGE
#undef PG8_LDA
#undef PG8_LDB
#undef PG8_MMA
#undef PG8_WAIT_V
#undef PG8_WAIT_L
#undef PG8_BAR
#undef PG8_SCHED
}
}

__device__ void phase_prologue(const Params& p, LAS unsigned char* lds) {
    int tid_ = threadIdx.x; asm volatile("" : "+v"(tid_)); const int tid = tid_;
    for (int i = blockIdx.x * 512 + tid; i < SEQ * 32; i += gridDim.x * 512) {
        const int pos = i >> 5, fi = i & 31;
        const float invf = exp2f(-(float)fi * (13.287712379549449f / 32.0f));
        const float ang = (float)pos * invf;
        double rev = (double)ang * 0.15915494309189535;
        rev -= rint(rev);
        const float rf = (float)rev;
        p.rope[i] = make_float2(__builtin_amdgcn_cosf(rf), __builtin_amdgcn_sinf(rf));
    }
    if (blockIdx.x == 0) {
        const int i = tid;
        float lg[DEPTH], mx = -1e30f;
#pragma unroll
        for (int l = 0; l < DEPTH; ++l) { lg[l] = p.lb_logits[l * 512 + i]; mx = fmaxf(mx, lg[l]); }
        float s = 0.f;
#pragma unroll
        for (int l = 0; l < DEPTH; ++l) { lg[l] = expf(lg[l] - mx); s += lg[l]; }
        const float inv = 1.0f / s; const float p0 = lg[0] * inv; float cum = 0.f;
#pragma unroll
        for (int l = 0; l < DEPTH; ++l) { cum += lg[l] * inv; p.lb[l * 512 + i] = fmaxf(cum - p0, 0.0f); }
    }
    LAS float* cact = (LAS float*)lds;
    LAS float* red = (LAS float*)(lds + 65536);
    for (int item = blockIdx.x; item < DEPTH * 48; item += gridDim.x) {
        const int l = item / 48, cb = item % 48;
        for (int i = tid; i < BATCH * D; i += 512) { const float c = p.c[i]; cact[i] = c * sigmoidf_(c); }
        __syncthreads();
        const int col = tid & 127, kq = tid >> 7;
        float acc[16];
#pragma unroll
        for (int b = 0; b < 16; ++b) acc[b] = 0.f;
        const float* wp = p.w_ada + ((size_t)l * D + kq * 256) * (6 * D) + cb * 128 + col;
        for (int k = 0; k < 256; k += 4) {
            const float w0 = wp[(size_t)k * (6 * D)], w1 = wp[(size_t)(k + 1) * (6 * D)], w2 = wp[(size_t)(k + 2) * (6 * D)], w3 = wp[(size_t)(k + 3) * (6 * D)];
#pragma unroll
            for (int b = 0; b < 16; ++b) { const f32x4 cv = *(const LAS f32x4*)(cact + b * D + kq * 256 + k); acc[b] += cv[0] * w0 + cv[1] * w1 + cv[2] * w2 + cv[3] * w3; }
        }
#pragma unroll
        for (int b = 0; b < 16; ++b) red[(kq * 16 + b) * 128 + col] = acc[b];
        __syncthreads();
        for (int e = tid; e < 16 * 128; e += 512) {
            const int b = e >> 7, cc = e & 127;
            const float s = red[(0 * 16 + b) * 128 + cc] + red[(1 * 16 + b) * 128 + cc] + red[(2 * 16 + b) * 128 + cc] + red[(3 * 16 + b) * 128 + cc];
            p.mod[((size_t)l * BATCH + b) * (6 * D) + cb * 128 + cc] = s + p.b_ada[l * 6 * D + cb * 128 + cc];
        }
        __syncthreads();
    }
}

struct ConvTile { const float* src; int ldsrc; bf16_t* dst; int K; int k0; int n0; int kind; const float* wa; };
__device__ __forceinline__ int conv_srccol(int kind, int n) {
    if (kind == 1) return n < 5632 ? n : n < 8704 ? n + 32 : -2;
    if (kind == 2) { const int pn = n >> 8, bj = (n >> 7) & 1, ii = n & 127; return bj * DFF + pn * 128 + ii; }
    return n;
}
__device__ __forceinline__ ConvTile conv_decode(const Params& p, int l, int t) {
    constexpr int T_IN = 16 * 144, T_P = 3 * 8 * 16, T_OUT = 16 * 16, T_FI = 16 * 88;
    int i = t; ConvTile c;
    if (i < T_IN) { c = ConvTile{p.w_in + (size_t)l * D * NIN, NIN, p.wt_in, D, (i & 15) * 64, (i >> 4) * 64, 1, p.w_alpha + (size_t)l * 2 * 16 * 256}; return c; }
    i -= T_IN;
    if (i < T_P) { const int br = i / 128, r = i % 128;
        c = ConvTile{(br == 0 ? p.w_pa : br == 1 ? p.w_pb : p.w_pc) + (size_t)l * 512 * D, D, p.wt_p + (size_t)br * D * 512, 512, (r & 7) * 64, (r >> 3) * 64, 0, nullptr}; return c; }
    i -= T_P;
    if (i < T_OUT) { c = ConvTile{p.w_out + (size_t)l * D * D, D, p.wt_out, D, (i & 15) * 64, (i >> 4) * 64, 0, nullptr}; return c; }
    i -= T_OUT;
    if (i < T_FI) { c = ConvTile{p.w_ffn_in + (size_t)l * D * 2 * DFF, 2 * DFF, p.wt_fi, D, (i & 15) * 64, (i >> 4) * 64, 2, nullptr}; return c; }
    i -= T_FI;
    c = ConvTile{p.w_ffn_out + (size_t)l * DFF * D, D, p.wt_fo, DFF, (i % 44) * 64, (i / 44) * 64, 0, nullptr}; return c;
}
__device__ __forceinline__ void conv_load(const ConvTile& c, int tid, float (&v)[8]) {
    const int cidx = tid & 63;
    if (c.kind == 1 && c.n0 >= 8704) {
        const int fc = c.n0 + cidx - 8704, dr = fc >> 8, ch = fc & 255;
        float wa[16];
#pragma unroll
        for (int r = 0; r < 16; ++r) wa[r] = c.wa[(dr * 16 + r) * 256 + ch];
#pragma unroll
        for (int i = 0; i < 8; ++i) { const int r_ = (tid >> 6) + 8 * i; const float* sp = c.src + (size_t)(c.k0 + r_) * c.ldsrc + 5632 + dr * 16;
            float a = 0.f;
#pragma unroll
            for (int q = 0; q < 4; ++q) { const f32x4 t = *(const f32x4*)(sp + q * 4); a += t[0] * wa[q * 4] + t[1] * wa[q * 4 + 1] + t[2] * wa[q * 4 + 2] + t[3] * wa[q * 4 + 3]; }
            v[i] = a; }
        return;
    }
    const int col4 = (tid & 15) * 4; const int sc4 = conv_srccol(c.kind, c.n0 + col4);
#pragma unroll
    for (int i = 0; i < 2; ++i) { const int r = (tid >> 4) + 32 * i; const f32x4 t = *(const f32x4*)(c.src + (size_t)(c.k0 + r) * c.ldsrc + sc4);
        v[i * 4] = t[0]; v[i * 4 + 1] = t[1]; v[i * 4 + 2] = t[2]; v[i * 4 + 3] = t[3]; }
}
__device__ __forceinline__ void conv_to_lds(const ConvTile& c, int tid, LAS float* tile, const float (&v)[8]) {
    if (c.kind == 1 && c.n0 >= 8704) {
#pragma unroll
        for (int i = 0; i < 8; ++i) tile[((tid >> 6) + 8 * i) * 65 + (tid & 63)] = v[i];
    } else {
#pragma unroll
        for (int i = 0; i < 2; ++i)
#pragma unroll
            for (int j = 0; j < 4; ++j) tile[((tid >> 4) + 32 * i) * 65 + (tid & 15) * 4 + j] = v[i * 4 + j];
    }
}
__device__ void phase_conv(const Params& p, LAS unsigned char* lds, int l) {
    LAS float* tile = (LAS float*)lds;
    constexpr int TOT = 16 * 144 + 3 * 8 * 16 + 16 * 16 + 16 * 88 + 44 * 16;
    int tid_ = threadIdx.x; asm volatile("" : "+v"(tid_)); const int tid = tid_;
    int t = blockIdx.x;
    if (t >= TOT) return;
    ConvTile cur = conv_decode(p, l, t);
    float v[8]; conv_load(cur, tid, v);
    for (;;) {
        const int tn = t + gridDim.x; const bool has_next = tn < TOT;
        conv_to_lds(cur, tid, tile, v);
        ConvTile nxt = cur;
        if (has_next) { nxt = conv_decode(p, l, tn); conv_load(nxt, tid, v); }
        __syncthreads();
        {
            const int n = tid >> 3, kk = (tid & 7) * 8;
            float w[8];
#pragma unroll
            for (int j = 0; j < 8; ++j) w[j] = tile[(kk + j) * 65 + n];
            *(u32x4*)(cur.dst + (size_t)(cur.n0 + n) * cur.K + cur.k0 + kk) = (u32x4){cvt_pk_bf16(w[0], w[1]), cvt_pk_bf16(w[2], w[3]), cvt_pk_bf16(w[4], w[5]), cvt_pk_bf16(w[6], w[7])};
        }
        __syncthreads();
        if (!has_next) break;
        cur = nxt; t = tn;
    }
}

__device__ void phase_norm(const float* xg  , const float* gain, const float* modg  , int shoff, int scoff, bf16_t* h, int nrows) {
    int tid_ = threadIdx.x; asm volatile("" : "+v"(tid_));
    const int lane = tid_ & 63, wid = tid_ >> 6;
    f32x4 g[4];
#pragma unroll
    for (int i = 0; i < 4; ++i) g[i] = *(const f32x4*)(gain + lane * 4 + i * 256);
    for (int rg = blockIdx.x; rg < nrows / 16; rg += gridDim.x) {
        f32x4 v[2][4], sc[4], sh[4]; float ss[2] = {0.f, 0.f};
        const float* mb = modg + (size_t)((rg * 16) / SEQ) * (6 * D);
#pragma unroll
        for (int t = 0; t < 2; ++t) { const float* xr = xg + (size_t)(rg * 16 + t * 8 + wid) * D;
#pragma unroll
            for (int i = 0; i < 4; ++i) v[t][i] = *(const f32x4*)(xr + lane * 4 + i * 256); }
#pragma unroll
        for (int i = 0; i < 4; ++i) { sc[i] = *(const f32x4*)(mb + scoff + lane * 4 + i * 256); sh[i] = *(const f32x4*)(mb + shoff + lane * 4 + i * 256); }
#pragma unroll
        for (int t = 0; t < 2; ++t) {
#pragma unroll
            for (int i = 0; i < 4; ++i) ss[t] += v[t][i][0] * v[t][i][0] + v[t][i][1] * v[t][i][1] + v[t][i][2] * v[t][i][2] + v[t][i][3] * v[t][i][3];
#pragma unroll
            for (int m = 32; m >= 1; m >>= 1) ss[t] += __shfl_xor(ss[t], m); }
#pragma unroll
        for (int t = 0; t < 2; ++t) {
            const int row = rg * 16 + t * 8 + wid;
            const float rstd = rsqrtf(ss[t] * (1.0f / D) + 1e-6f);
#pragma unroll
            for (int i = 0; i < 4; ++i) { const int c = lane * 4 + i * 256;
                const f32x4 r = v[t][i] * rstd * g[i] * (sc[i] + 1.0f) + sh[i];
                *(u32x2*)(h + (size_t)row * D + c) = (u32x2){cvt_pk_bf16(r[0], r[1]), cvt_pk_bf16(r[2], r[3])}; }
        }
    }
}
__device__ void phase_final(const Params& p) {
    int tid_ = threadIdx.x; asm volatile("" : "+v"(tid_));
    const int lane = tid_ & 63, wid = tid_ >> 6;
    f32x4 g[4];
#pragma unroll
    for (int i = 0; i < 4; ++i) g[i] = *(const f32x4*)(p.norm_f_g + lane * 4 + i * 256);
    for (int rg = blockIdx.x; rg < BATCH * SEQ / 16; rg += gridDim.x) {
        f32x4 v[2][4]; float ss[2];
#pragma unroll
        for (int t = 0; t < 2; ++t) { const float* xr = p.out + (size_t)(rg * 16 + t * 8 + wid) * D;
#pragma unroll
            for (int i = 0; i < 4; ++i) v[t][i] = *(const f32x4*)(xr + lane * 4 + i * 256); }
#pragma unroll
        for (int t = 0; t < 2; ++t) { ss[t] = 0.f;
#pragma unroll
            for (int i = 0; i < 4; ++i) ss[t] += v[t][i][0] * v[t][i][0] + v[t][i][1] * v[t][i][1] + v[t][i][2] * v[t][i][2] + v[t][i][3] * v[t][i][3];
#pragma unroll
            for (int m = 32; m >= 1; m >>= 1) ss[t] += __shfl_xor(ss[t], m); }
#pragma unroll
        for (int t = 0; t < 2; ++t) { float* xr = p.out + (size_t)(rg * 16 + t * 8 + wid) * D;
            const float rstd = rsqrtf(ss[t] * (1.0f / D) + 1e-6f);
#pragma unroll
            for (int i = 0; i < 4; ++i) *(f32x4*)(xr + lane * 4 + i * 256) = v[t][i] * rstd * g[i]; }
    }
}

template <int DK, int DV, int MIX>
__device__ void scan_item(const Params& p, LAS unsigned char* lds, int layer, int bl, int head, int dir, int vhalf) {
    constexpr int TG = 512 / DK, TPG = 64 / TG;
    constexpr int TGV = 512 / DV, TPGV = 64 / TGV;
    constexpr int SQ = DK * 2 + 16, S64 = 144;
    constexpr int OFF_QT = 0, OFF_KT = OFF_QT + 64 * SQ, OFF_QS = OFF_KT + 64 * SQ, OFF_KL = OFF_QS + 64 * SQ, OFF_VT = OFF_KL + DK * S64,
                  OFF_P = OFF_VT + DV * S64, OFF_ST = OFF_P + 64 * S64, OFF_TOT = OFF_ST + DV * SQ, OFF_EL = OFF_TOT + TG * DK * 4,
                  OFF_RQ = OFF_EL + DK * 4, OFF_RK = OFF_RQ + 64 * DK * 2, OFF_RV = OFF_RK + 64 * DK * 2, OFF_RL = OFF_RV + 64 * DV * 2, OFF_END = OFF_RL + (MIX == 2 ? 64 * 128 : 0);
    static_assert(OFF_END <= LDS_MAIN, "lds");
    static_assert(OFF_RQ % 1024 == 0 || true, "");
    constexpr int NV = DV / 32;
    int tid_ = threadIdx.x; asm volatile("" : "+v"(tid_));
    const int tid = tid_, lane = tid & 63, wid = __builtin_amdgcn_readfirstlane(tid >> 6), fr = lane & 15, fq = lane >> 4;
    const int d = tid % DK, g = tid / DK, vv = tid % DV, gv = tid / DV;
    const bf16_t* zb = p.z + (size_t)(bl * SEQ) * NZ;
    int cbq, cbk, cbv;
    if (MIX == 0) { cbq = ZA_Q + head * 128; cbk = (dir ? ZA_FB : ZA_FF) + head * 128; cbv = ZA_I + head * 128 + vhalf * 64; }
    else if (MIX == 1) { cbq = ZB_Q + head * 64; cbk = ZB_K + head * 64; cbv = ZB_V + head * 128; }
    else { cbq = ZC_Q + head * 64; cbk = ZC_K + head * 64; cbv = ZC_V + head * 128; }
    float lbv = 0.f, oml = 1.f, gam = 1.f, bal = 0.f;
    if (MIX == 0) { lbv = p.lb[layer * 512 + head * 128 + d]; oml = 1.0f - lbv; }
    if (MIX == 1) { const int hh = dir ? 3 - head : head; gam = 1.0f - exp2f(-5.0f - (float)hh); }
    if (MIX == 2) bal = p.b_alpha[((size_t)layer * 2 + dir) * 256 + head * 64 + d];
    const int cbl = ZC_LG + dir * 256 + head * 64;
    float2 cbn = make_float2(1.f, 0.f);
    if (MIX == 1) cbn = p.rope[((dir ? 31 : 0) * 64) * 32 + (d & 31)];
    float2 rin[TPG];
    if (MIX == 1) {
#pragma unroll
        for (int tt = 0; tt < TPG; ++tt) { const int ip = g * TPG + tt; rin[tt] = p.rope[(dir ? 63 - ip : ip) * 32 + (d & 31)]; }
    }
    f32x4 S[4];
#pragma unroll
    for (int q = 0; q < 4; ++q) S[q] = (f32x4){0.f, 0.f, 0.f, 0.f};
    for (int i = tid * 16; i < DV * SQ; i += 512 * 16) *(LAS u32x4*)(lds + OFF_ST + i) = (u32x4){0u, 0u, 0u, 0u};
    const int ti = wid & 3;
    const int tj0 = (wid >> 2) * 2;
    const int tv0 = (wid >> 2) * NV;

    auto stage_rows = [&](int cn, int ldsoff, int colbase, int rbshift  ) {
        const int n = dir ? 31 - cn : cn;
        const bf16_t* zc = zb + (size_t)(n * 64) * NZ + colbase;
        const int rpw = 1024 >> rbshift, nwl = 64 / rpw, l16 = (1 << rbshift) >> 4;
        for (int wl = wid; wl < nwl; wl += 8) {
            const int row = wl * rpw + lane / l16, c16 = lane % l16; const int tk = dir ? 63 - row : row;
            __builtin_amdgcn_global_load_lds((const unsigned*)(zc + (size_t)tk * NZ + c16 * 8), (LAS unsigned*)(lds + ldsoff + wl * 1024), 16, 0, 0);
        }
    };
    constexpr int RBQ = (DK == 128) ? 8 : 7, RBV = (DV == 128) ? 8 : 7;
    stage_rows(0, OFF_RQ, cbq, RBQ); stage_rows(0, OFF_RK, cbk, RBQ); stage_rows(0, OFF_RV, cbv, RBV);
    if (MIX == 2) stage_rows(0, OFF_RL, cbl, 7);
    asm volatile("s_waitcnt vmcnt(0)" ::: "memory");
    __syncthreads();

    for (int cn = 0; cn < 32; ++cn) {
        const int n = dir ? 31 - cn : cn;
        float qv[TPG], kv[TPG], pl[TPG], sl[TPG];
        {
            float f[TPG];
            float2 rcs[TPG];
            if (MIX == 1) {
                const float2 cb = cbn;
                if (cn + 1 < 32) cbn = p.rope[((dir ? 30 - cn : cn + 1) * 64) * 32 + (d & 31)];
#pragma unroll
                for (int tt = 0; tt < TPG; ++tt) rcs[tt] = make_float2(cb.x * rin[tt].x - cb.y * rin[tt].y, cb.y * rin[tt].x + cb.x * rin[tt].y);
            }
#pragma unroll
            for (int tt = 0; tt < TPG; ++tt) {
                const int ip = g * TPG + tt;
                if (MIX == 0) {
                    qv[tt] = bf2f(*(const LAS bf16_t*)(lds + OFF_RQ + ip * (DK * 2) + d * 2));
                    const float sg = bf2f(*(const LAS bf16_t*)(lds + OFF_RK + ip * (DK * 2) + d * 2));
                    f[tt] = fmaxf(lbv + oml * sg, 1e-30f); kv[tt] = oml * (1.0f - sg);
                } else if (MIX == 1) {
                    const int dl = d & 31;
                    const float q1 = bf2f(*(const LAS bf16_t*)(lds + OFF_RQ + ip * (DK * 2) + dl * 2)), q2 = bf2f(*(const LAS bf16_t*)(lds + OFF_RQ + ip * (DK * 2) + dl * 2 + 64));
                    const float k1 = bf2f(*(const LAS bf16_t*)(lds + OFF_RK + ip * (DK * 2) + dl * 2)), k2 = bf2f(*(const LAS bf16_t*)(lds + OFF_RK + ip * (DK * 2) + dl * 2 + 64));
                    const float2 cs = rcs[tt];
                    if (d < 32) { qv[tt] = q1 * cs.x - q2 * cs.y; kv[tt] = (k1 * cs.x - k2 * cs.y) * 0.125f; }
                    else        { qv[tt] = q1 * cs.y + q2 * cs.x; kv[tt] = (k1 * cs.y + k2 * cs.x) * 0.125f; }
                    f[tt] = gam;
                } else {
                    qv[tt] = bf2f(*(const LAS bf16_t*)(lds + OFF_RQ + ip * (DK * 2) + d * 2)) * 0.125f; kv[tt] = bf2f(*(const LAS bf16_t*)(lds + OFF_RK + ip * (DK * 2) + d * 2));
                    const float logit = bal + bf2f(*(const LAS bf16_t*)(lds + OFF_RL + ip * 128 + d * 2));
                    const float lg = (fminf(logit, 0.f) - __logf(1.0f + __expf(-fabsf(logit)))) * (1.0f / 16.0f);
                    f[tt] = __expf(lg);
                }
            }
            pl[0] = f[0];
#pragma unroll
            for (int tt = 1; tt < TPG; ++tt) pl[tt] = pl[tt - 1] * f[tt];
            sl[TPG - 1] = 1.0f;
#pragma unroll
            for (int tt = TPG - 2; tt >= 0; --tt) sl[tt] = sl[tt + 1] * f[tt + 1];
        }
        ((LAS float*)(lds + OFF_TOT))[g * DK + d] = pl[TPG - 1];
        __syncthreads();
        if (cn + 1 < 32) { stage_rows(cn + 1, OFF_RQ, cbq, RBQ); stage_rows(cn + 1, OFF_RK, cbk, RBQ); if (MIX == 2) stage_rows(cn + 1, OFF_RL, cbl, 7); }
        {
            unsigned vp[TPGV / 2];
#pragma unroll
            for (int tt = 0; tt < TPGV; tt += 2) { const int ip = gv * TPGV + tt;
                vp[tt >> 1] = (unsigned)*(const LAS bf16_t*)(lds + OFF_RV + ip * (DV * 2) + vv * 2) | ((unsigned)*(const LAS bf16_t*)(lds + OFF_RV + (ip + 1) * (DV * 2) + vv * 2) << 16); }
            float H1 = 1.f, H2 = 1.f, R = 1.f, Fh = 1.f, Gl = 1.f, Gh = 1.f;
#pragma unroll
            for (int gg = 0; gg < TG; ++gg) { const float t = ((LAS float*)(lds + OFF_TOT))[gg * DK + d];
                if (gg < TG / 2) { H1 *= t; if (gg >= g) R *= t; if (gg > g) Gl *= t; }
                else { H2 *= t; if (gg < g) Fh *= t; if (gg > g) Gh *= t; } }
            const float Fg = (g < TG / 2) ? __builtin_amdgcn_rcpf(fmaxf(R, 1e-30f)) : Fh;
            const float Gg = (g < TG / 2) ? Gl : Gh * __builtin_amdgcn_rcpf(fmaxf(H2, 1e-30f));
            if (g == 0) ((LAS float*)(lds + OFF_EL))[d] = H1 * H2;
            unsigned klp[TPG / 2];
#pragma unroll
            for (int tt = 0; tt < TPG; tt += 2) {
                const int ip = g * TPG + tt;
                const float qa = qv[tt] * (pl[tt] * Fg), qb = qv[tt + 1] * (pl[tt + 1] * Fg);
                const float ka = kv[tt] * (sl[tt] * Gg), kb = kv[tt + 1] * (sl[tt + 1] * Gg);
                const unsigned wq = cvt_pk_bf16(qa, qb), wk = cvt_pk_bf16(ka, kb), ws = cvt_pk_bf16(qa * H1, qb * H1);
                *(LAS bf16_t*)(lds + OFF_QT + ip * SQ + d * 2) = (bf16_t)wq; *(LAS bf16_t*)(lds + OFF_QT + (ip + 1) * SQ + d * 2) = (bf16_t)(wq >> 16);
                *(LAS bf16_t*)(lds + OFF_KT + ip * SQ + d * 2) = (bf16_t)wk; *(LAS bf16_t*)(lds + OFF_KT + (ip + 1) * SQ + d * 2) = (bf16_t)(wk >> 16);
                *(LAS bf16_t*)(lds + OFF_QS + ip * SQ + d * 2) = (bf16_t)ws; *(LAS bf16_t*)(lds + OFF_QS + (ip + 1) * SQ + d * 2) = (bf16_t)(ws >> 16);
                klp[tt >> 1] = cvt_pk_bf16(ka * H2, kb * H2);
            }
#pragma unroll
            for (int q = 0; q < TPG / 8; ++q) *(LAS u32x4*)(lds + OFF_KL + d * S64 + (g * TPG + q * 8) * 2) = (u32x4){klp[q * 4], klp[q * 4 + 1], klp[q * 4 + 2], klp[q * 4 + 3]};
#pragma unroll
            for (int q = 0; q < TPGV / 8; ++q) *(LAS u32x4*)(lds + OFF_VT + vv * S64 + (gv * TPGV + q * 8) * 2) = (u32x4){vp[q * 4], vp[q * 4 + 1], vp[q * 4 + 2], vp[q * 4 + 3]};
        }
        __syncthreads();
        if (cn + 1 < 32) stage_rows(cn + 1, OFF_RV, cbv, RBV);
        f32x4 oa[NV];
        {
            f32x4 sc[2] = {(f32x4){0.f, 0.f, 0.f, 0.f}, (f32x4){0.f, 0.f, 0.f, 0.f}};
#pragma unroll
            for (int q = 0; q < NV; ++q) oa[q] = (f32x4){0.f, 0.f, 0.f, 0.f};
#pragma unroll
            for (int ks = 0; ks < DK / 32; ++ks) {
                const bf16x8 bq = *(const LAS bf16x8*)(lds + OFF_QT + (ti * 16 + fr) * SQ + ks * 64 + fq * 16);
#pragma unroll
                for (int jj = 0; jj < 2; ++jj) { const bf16x8 ak = *(const LAS bf16x8*)(lds + OFF_KT + ((tj0 + jj) * 16 + fr) * SQ + ks * 64 + fq * 16);
                    sc[jj] = __builtin_amdgcn_mfma_f32_16x16x32_bf16(ak, bq, sc[jj], 0, 0, 0); }
                const bf16x8 bs = *(const LAS bf16x8*)(lds + OFF_QS + (ti * 16 + fr) * SQ + ks * 64 + fq * 16);
#pragma unroll
                for (int q = 0; q < NV; ++q) { const bf16x8 as = *(const LAS bf16x8*)(lds + OFF_ST + ((tv0 + q) * 16 + fr) * SQ + ks * 64 + fq * 16);
                    oa[q] = __builtin_amdgcn_mfma_f32_16x16x32_bf16(as, bs, oa[q], 0, 0, 0); }
            }
            const int ipc = ti * 16 + fr;
#pragma unroll
            for (int jj = 0; jj < 2; ++jj) { const int jp0 = (tj0 + jj) * 16 + fq * 4; float m[4];
#pragma unroll
                for (int r = 0; r < 4; ++r) { const int jp = jp0 + r; const bool keep = dir ? (jp < ipc) : (jp <= ipc); m[r] = keep ? sc[jj][r] : 0.f; }
                *(LAS u32x2*)(lds + OFF_P + ipc * S64 + jp0 * 2) = (u32x2){cvt_pk_bf16(m[0], m[1]), cvt_pk_bf16(m[2], m[3])}; }
        }
        asm volatile("s_waitcnt vmcnt(0)" ::: "memory");
        __syncthreads();
        {
#pragma unroll
            for (int ks = 0; ks < 2; ++ks) {
                const bf16x8 bp = *(const LAS bf16x8*)(lds + OFF_P + (ti * 16 + fr) * S64 + ks * 64 + fq * 16);
#pragma unroll
                for (int q = 0; q < NV; ++q) { const bf16x8 av = *(const LAS bf16x8*)(lds + OFF_VT + ((tv0 + q) * 16 + fr) * S64 + ks * 64 + fq * 16);
                    oa[q] = __builtin_amdgcn_mfma_f32_16x16x32_bf16(av, bp, oa[q], 0, 0, 0); }
            }
            const int ip = ti * 16 + fr; const int tk = dir ? 63 - ip : ip;
            bf16_t* op = p.o + ((size_t)(dir * 3 + MIX) * MH + bl * SEQ + n * 64 + tk) * 512 + head * 128 + vhalf * 64;
#pragma unroll
            for (int q = 0; q < NV; ++q) *(u32x2*)(op + (tv0 + q) * 16 + fq * 4) = (u32x2){cvt_pk_bf16(oa[q][0], oa[q][1]), cvt_pk_bf16(oa[q][2], oa[q][3])};
        }
#pragma unroll
        for (int q = 0; q < 4; ++q) {
            const int tix = wid * 4 + q, td = tix / (DV / 16), tv = tix % (DV / 16);
            const f32x4 el = *(const LAS f32x4*)(lds + OFF_EL + (td * 16 + fq * 4) * 4);
            S[q] *= el;
#pragma unroll
            for (int ks = 0; ks < 2; ++ks) {
                const bf16x8 ak = *(const LAS bf16x8*)(lds + OFF_KL + (td * 16 + fr) * S64 + ks * 64 + fq * 16);
                const bf16x8 bv = *(const LAS bf16x8*)(lds + OFF_VT + (tv * 16 + fr) * S64 + ks * 64 + fq * 16);
                S[q] = __builtin_amdgcn_mfma_f32_16x16x32_bf16(ak, bv, S[q], 0, 0, 0);
            }
            *(LAS u32x2*)(lds + OFF_ST + (tv * 16 + fr) * SQ + (td * 16 + fq * 4) * 2) = (u32x2){cvt_pk_bf16(S[q][0], S[q][1]), cvt_pk_bf16(S[q][2], S[q][3])};
        }
    }
    asm volatile("s_waitcnt vmcnt(0)" ::: "memory");
    __syncthreads();
}
__device__ void phase_scan(const Params& p, LAS unsigned char* lds, int layer) {
    for (int item = blockIdx.x; item < 256; item += gridDim.x) {
        if (item < 128) { const int vhalf = item & 1, dir = (item >> 1) & 1, head = (item >> 2) & 3, bl = item >> 4; scan_item<128, 64, 0>(p, lds, layer, bl, head, dir, vhalf); }
        else if (item < 192) { const int i = item - 128, dir = i & 1, head = (i >> 1) & 3, bl = i >> 3; scan_item<64, 128, 1>(p, lds, layer, bl, head, dir, 0); }
        else { const int i = item - 192, dir = i & 1, head = (i >> 1) & 3, bl = i >> 3; scan_item<64, 128, 2>(p, lds, layer, bl, head, dir, 0); }
    }
}

__device__ void phase_ypass(const Params& p, int layer) {
    int tid_ = threadIdx.x; asm volatile("" : "+v"(tid_));
    const int lane = tid_ & 63, wid = tid_ >> 6;
    const int ch = (lane >> 4) * 128 + (lane & 15) * 8;
    f32x4 gn[3][2];
#pragma unroll
    for (int br = 0; br < 3; ++br) { const float* g = (br == 0 ? p.norm_a_g : br == 1 ? p.norm_b_g : p.norm_c_g) + layer * 512 + ch; gn[br][0] = *(const f32x4*)g; gn[br][1] = *(const f32x4*)(g + 4); }
    for (int rg = blockIdx.x; rg < MH / 16; rg += gridDim.x) {
        u32x4 a[2][3], b[2][3], gz[2][3];
#pragma unroll
        for (int t = 0; t < 2; ++t) { const int tok = rg * 16 + t * 8 + wid; const bf16_t* zr = p.z + (size_t)tok * NZ;
#pragma unroll
            for (int br = 0; br < 3; ++br) {
                a[t][br] = *(const u32x4*)(p.o + ((size_t)br * MH + tok) * 512 + ch);
                b[t][br] = *(const u32x4*)(p.o + ((size_t)(3 + br) * MH + tok) * 512 + ch);
                gz[t][br] = *(const u32x4*)(zr + (br == 0 ? ZA_G : br == 1 ? ZB_G : ZC_G) + ch); } }
#pragma unroll
        for (int t = 0; t < 2; ++t) { const int tok = rg * 16 + t * 8 + wid;
#pragma unroll
            for (int br = 0; br < 3; ++br) {
                float s[8], gt[8];
#pragma unroll
                for (int e = 0; e < 4; ++e) {
                    s[2 * e] = __uint_as_float(a[t][br][e] << 16) + __uint_as_float(b[t][br][e] << 16);
                    s[2 * e + 1] = __uint_as_float(a[t][br][e] & 0xffff0000u) + __uint_as_float(b[t][br][e] & 0xffff0000u);
                    gt[2 * e] = __uint_as_float(gz[t][br][e] << 16); gt[2 * e + 1] = __uint_as_float(gz[t][br][e] & 0xffff0000u); }
                float mu = 0.f;
                if (br == 1) {
#pragma unroll
                    for (int j = 0; j < 8; ++j) mu += s[j];
#pragma unroll
                    for (int m = 8; m >= 1; m >>= 1) mu += __shfl_xor(mu, m);
                    mu *= (1.0f / 128.0f);
                }
                float ss = 0.f;
#pragma unroll
                for (int j = 0; j < 8; ++j) { s[j] -= mu; ss += s[j] * s[j]; }
#pragma unroll
                for (int m = 8; m >= 1; m >>= 1) ss += __shfl_xor(ss, m);
                const float rstd = rsqrtf(ss * (1.0f / 128.0f) + 1e-6f);
                float r[8];
#pragma unroll
                for (int j = 0; j < 8; ++j) { const float gn_ = gn[br][j >> 2][j & 3]; const float sg = sigmoidf_(gt[j]);
                    const float act = br == 0 ? sg : gt[j] * sg; r[j] = s[j] * rstd * gn_ * act; }
                *(u32x4*)(p.o + ((size_t)br * MH + tok) * 512 + ch) = (u32x4){cvt_pk_bf16(r[0], r[1]), cvt_pk_bf16(r[2], r[3]), cvt_pk_bf16(r[4], r[5]), cvt_pk_bf16(r[6], r[7])};
            } }
    }
}

#define XB_TMO      128
#define XB_XCNT(j)  (256  + 64 * (j))
#define XB_XSUB(j)  (1280 + 64 * (j))
#define XB_XGEN(j)  (2304 + 64 * (j))
#define XB_TOP      3328
#define XB_TOPGEN   3392
#define XCD_BAR_WORDS 3456
#define XB_SPIN_CAP (1u << 22)
__device__ __forceinline__ unsigned xb_ld(unsigned* p)              { return __hip_atomic_load(p, __ATOMIC_RELAXED, __HIP_MEMORY_SCOPE_AGENT); }
__device__ __forceinline__ unsigned xb_add(unsigned* p, unsigned v) { return __hip_atomic_fetch_add(p, v, __ATOMIC_RELAXED, __HIP_MEMORY_SCOPE_AGENT); }
__device__ __forceinline__ unsigned xb_xcc_id() { return (unsigned)__builtin_amdgcn_s_getreg((3 << 11) | 20) & 0xFu; }
#define XB_SPIN(cond, bar) do { unsigned _sp = 0; while (cond) { __builtin_amdgcn_s_sleep(1); \
    if ((++_sp & 255u) == 0u) { if (xb_ld(&(bar)[XB_TMO])) break; if (_sp > XB_SPIN_CAP) { atomicAdd(&(bar)[XB_TMO], 1u); break; } } } } while (0)
struct XcdBarrier { unsigned* bar; unsigned x; volatile LAS unsigned* st; };
__device__ __forceinline__ XcdBarrier xcd_barrier_post(unsigned* bar, volatile LAS unsigned* st) {
    XcdBarrier b; b.bar = bar; b.x = xb_xcc_id(); b.st = st;
    if (threadIdx.x == 0) (void)xb_add(&bar[XB_XCNT(b.x)], 1u);
    return b;
}
__device__ __forceinline__ void xcd_barrier_complete(unsigned* bar, unsigned x, unsigned& nloc, unsigned& nx) {
    const unsigned G = gridDim.x * gridDim.y * gridDim.z;
    unsigned sum, cnt, mine, sp = 0u;
    for (;;) {
        sum = 0u; cnt = 0u; mine = 0u;
#pragma unroll
        for (unsigned j = 0; j < 16; ++j) { const unsigned c = xb_ld(&bar[XB_XCNT(j)]); sum += c; cnt += (c > 0u) ? 1u : 0u; mine = (j == x) ? c : mine; }
        if (sum == G) break;
        __builtin_amdgcn_s_sleep(1);
        if ((++sp & 255u) == 0u) { if (xb_ld(&bar[XB_TMO])) break; if (sp > XB_SPIN_CAP) { atomicAdd(&bar[XB_TMO], 1u); break; } }
    }
    nloc = mine > 0u ? mine : 1u; nx = cnt > 0u ? cnt : 1u;
}
__device__ __forceinline__ void xcd_barrier(const XcdBarrier& b) {
    asm volatile("s_waitcnt vmcnt(0)" ::: "memory");
    __syncthreads();
    if (threadIdx.x == 0) {
        unsigned* bar = b.bar;
        __builtin_amdgcn_s_waitcnt(0);
        unsigned nloc = b.st[0], nx = b.st[1];
        if (nloc == 0u) { xcd_barrier_complete(bar, b.x, nloc, nx); b.st[0] = nloc; b.st[1] = nx; }
        const unsigned old = xb_add(&bar[XB_XSUB(b.x)], 1u);
        const unsigned gen = old / nloc;
        if (old + 1u == (gen + 1u) * nloc) {
            __builtin_amdgcn_fence(__ATOMIC_RELEASE, "agent");
            asm volatile("s_waitcnt vmcnt(0)" ::: "memory");
            const unsigned og = xb_add(&bar[XB_TOP], 1u);
            const unsigned tg = og / nx;
            if (og + 1u == (tg + 1u) * nx) xb_add(&bar[XB_TOPGEN], 1u);
            else XB_SPIN(xb_ld(&bar[XB_TOPGEN]) == tg, bar);
            __builtin_amdgcn_fence(__ATOMIC_ACQUIRE, "agent");
            xb_add(&bar[XB_XGEN(b.x)], 1u);
            asm volatile("s_waitcnt vmcnt(0)" ::: "memory");
        } else {
            XB_SPIN(xb_ld(&bar[XB_XGEN(b.x)]) == gen, bar);
            __builtin_amdgcn_fence(__ATOMIC_ACQUIRE, "agent");
            asm volatile("s_waitcnt vmcnt(0)" ::: "memory");
        }
    }
    __syncthreads();
}

constexpr int N_PHASES = 1 + DEPTH * (1 + 1 + NGRP * 4 + 3) + 1;

__global__ void __launch_bounds__(512, 2) mega(Params p, int ph0, int ph1) {
    extern __shared__ __attribute__((aligned(16))) unsigned char shm[];
    LAS unsigned char* lds = (LAS unsigned char*)shm;
    cg::grid_group grid = cg::this_grid();
    volatile LAS unsigned* xst = (volatile LAS unsigned*)(lds + LDS_MAIN);
    if (threadIdx.x == 0) { xst[0] = 0u; xst[1] = 0u; }
    __syncthreads();
    const XcdBarrier xb = xcd_barrier_post(p.bar, xst);
    int pc = 0;
#define PHASE_BEGIN if (pc >= ph0 && pc < ph1) {
#define PHASE_END   if (pc + 1 < ph1) { if (ph1 < 0) grid.sync(); else xcd_barrier(xb); } } ++pc;
    PHASE_BEGIN
        phase_prologue(p, lds);
        phase_conv(p, lds, 0);
    PHASE_END
    for (int l = 0; l < DEPTH; ++l) {
        const float* modL = p.mod + (size_t)l * BATCH * (6 * D);
        const float* xinL = (l == 0 ? p.x : p.out);
        PHASE_BEGIN
            if (l > 0) phase_conv(p, lds, l);
            phase_norm(xinL, p.norm1_g + l * D, modL, 0, D, p.h, 2 * MH);
        PHASE_END
        for (int grp = 0; grp < NGRP; ++grp) {
            const float* modg = modL + (size_t)grp * GB * (6 * D);
            float* xg = p.out + (size_t)grp * MH * D;
            const float* xin0 = xinL + (size_t)grp * MH * D;
            bf16_t* hg = p.h + (size_t)grp * MH * D;
            if (grp == 0) {
            PHASE_BEGIN
                pg8::Gemm g{hg, p.wt_in, D, D, D}; pg8::ProjOrder S; S.base.init(MH, NZ, gridDim.x, blockIdx.x);
                pg8::EpiZ E{p.z, NZ}; pg8::gemm_phase(lds, g, S, E);
            PHASE_END
            }
            PHASE_BEGIN
                phase_scan(p, lds, l);
            PHASE_END
            PHASE_BEGIN
                phase_ypass(p, l);
            PHASE_END
            PHASE_BEGIN
                pg8::Gemm g{p.o, p.wt_p, 512, 512, 512}; pg8::MergeOrder S; S.base.init(MH, D, gridDim.x, blockIdx.x);
                pg8::EpiMerge E{p.z, hg}; pg8::gemm_phase(lds, g, S, E);
            PHASE_END
            PHASE_BEGIN
                { pg8::Gemm g{hg, p.wt_out, D, D, D}; pg8::StaticOrder S; S.init(MH, D, gridDim.x, blockIdx.x);
                  pg8::EpiRes E{xin0, xg, modg + 2 * D}; pg8::gemm_phase(lds, g, S, E); }
                if (grp == 0) {
                    pg8::Gemm g{p.h + (size_t)MH * D, p.wt_in, D, D, D}; pg8::ProjOrder S; S.base.init(MH, NZ, gridDim.x, blockIdx.x);
                    pg8::EpiZ E{p.z, NZ}; pg8::gemm_phase(lds, g, S, E);
                }
            PHASE_END
        }
        {
            const float* modl = p.mod + (size_t)l * BATCH * (6 * D);
            PHASE_BEGIN
                phase_norm(p.out, p.norm2_g + l * D, modl, 3 * D, 4 * D, p.h2, 2 * MH);
            PHASE_END
            PHASE_BEGIN
                pg8::Gemm g{p.h2, p.wt_fi, D, D, D}; pg8::StaticOrder S; S.init(2 * MH, 2 * DFF, gridDim.x, blockIdx.x);
                pg8::EpiAct E{p.z, DFF}; pg8::gemm_phase(lds, g, S, E);
            PHASE_END
            PHASE_BEGIN
                pg8::Gemm g{p.z, p.wt_fo, DFF, DFF, DFF}; pg8::StaticOrder S; S.init(2 * MH, D, gridDim.x, blockIdx.x);
                pg8::EpiRes E{p.out, p.out, modl + 5 * D}; pg8::gemm_phase(lds, g, S, E);
            PHASE_END
        }
    }
    PHASE_BEGIN
        phase_final(p);
    PHASE_END
}

extern "C" void kernel_launch(void* const* d_in, const int* in_sizes, int n_in, void* d_out, int out_size, void* d_ws, size_t ws_size, hipStream_t stream) {
    Params p{};
    const float** f = (const float**)&p;
    for (int i = 0; i < 20; ++i) f[i] = (const float*)d_in[i];
    p.out = (float*)d_out;
    char* w = (char*)d_ws; size_t off = 0;
    auto take = [&](size_t bytes) { char* r = w + off; off += (bytes + 255) & ~(size_t)255; return r; };
    p.wt_in = (bf16_t*)take((size_t)NZ * D * 2);
    p.wt_p = (bf16_t*)take((size_t)3 * D * 512 * 2);
    p.wt_out = (bf16_t*)take((size_t)D * D * 2);
    p.wt_fi = (bf16_t*)take((size_t)2 * DFF * D * 2);
    p.wt_fo = (bf16_t*)take((size_t)D * DFF * 2);
    p.mod = (float*)take((size_t)DEPTH * BATCH * 6 * D * 4);
    p.lb = (float*)take((size_t)DEPTH * 512 * 4);
    p.rope = (float2*)take((size_t)SEQ * 32 * 8);
    p.h = (bf16_t*)take((size_t)2 * MH * D * 2);
    p.h2 = p.h;
    p.z = (bf16_t*)take((size_t)MH * NZ * 2);
    p.o = (bf16_t*)take((size_t)2 * 3 * MH * 512 * 2);
    p.bar = (unsigned*)take((size_t)XCD_BAR_WORDS * 4);
    if (off > ws_size) { fprintf(stderr, "workspace too small: need %zu have %zu\n", off, ws_size); return; }
    static int grid_blocks = 0;
    if (!grid_blocks) {
        (void)hipFuncSetAttribute((const void*)mega, hipFuncAttributeMaxDynamicSharedMemorySize, LDS_BYTES);
        int dev = 0, cus = 0, per_cu = 0;
        (void)hipGetDevice(&dev);
        (void)hipDeviceGetAttribute(&cus, hipDeviceAttributeMultiprocessorCount, dev);
        (void)hipOccupancyMaxActiveBlocksPerMultiprocessor(&per_cu, mega, 512, LDS_BYTES);
        if (per_cu < 1) per_cu = 1;
        grid_blocks = cus * 1;
    }
    (void)hipMemsetAsync(p.bar, 0, (size_t)XCD_BAR_WORDS * 4, stream);
#if MULTI_LAUNCH
    for (int ph = 0; ph < N_PHASES; ++ph)
        hipLaunchKernelGGL(mega, dim3(grid_blocks), dim3(512), LDS_BYTES, stream, p, ph, ph + 1);
#else
    int ph0 = 0, ph1 = N_PHASES;
    void* args[] = {&p, &ph0, &ph1};
    hipError_t e = hipLaunchCooperativeKernel((void*)mega, dim3(grid_blocks), dim3(512), args, LDS_BYTES, stream);
    if (e != hipSuccess) fprintf(stderr, "cooperative launch failed: %s (grid %d)\n", hipGetErrorString(e), grid_blocks);
#endif
}
```
